# Optimizing an MI355X kernel written in HIP

```python
import jax, jax.numpy as jnp
from jax import lax
import numpy as np

D_MODEL = 1024
BATCH = 8
SEQ = 2048
DEPTH = 4

N_META = 16
EXPAND = 2
D_INNER = EXPAND * D_MODEL
POOL_WINDOWS = (2, 4, 8, 16)
N_POOL_GROUPS = len(POOL_WINDOWS)
POOL_GROUP = D_INNER // N_POOL_GROUPS
GLA_HEADS = 4
GLA_DK_TOTAL = D_INNER // 2
GLA_DK = GLA_DK_TOTAL // GLA_HEADS
GLA_DV = D_INNER // GLA_HEADS
GATE_RANK = 16
GATE_TAU = 16.0
CHUNK = 64
EPS = 1e-6
N_POOL_LAYERS = (DEPTH + 1) // 2
N_GLA_LAYERS = DEPTH // 2
GLA_IN = 2 * GLA_DK_TOTAL + 2 * D_INNER + GATE_RANK

kernel_name = "hybrid_pool_gla_meta_trunk"


def rmsnorm(x, g):
    xf = x.astype(jnp.float32)
    y = xf * lax.rsqrt(jnp.mean(xf * xf, axis=-1, keepdims=True) + EPS)
    return (y * g.astype(jnp.float32)).astype(x.dtype)


def pool_mixer(h, w_in, w_grp, scale, w_out):
    B, L, _ = h.shape
    u, z = jnp.split(h @ w_in, 2, axis=-1)
    uf = u.astype(jnp.float32).reshape(B, L, N_POOL_GROUPS, POOL_GROUP)
    c = jnp.cumsum(uf, axis=1)
    pos = jnp.arange(1, L + 1, dtype=jnp.float32)
    pooled = []
    for gi, w in enumerate(POOL_WINDOWS):
        cg = c[:, :, gi]
        shifted = jnp.pad(cg, ((0, 0), (w, 0), (0, 0)))[:, :L]
        cnt = jnp.minimum(pos, float(w))[None, :, None]
        pooled.append((cg - shifted) / cnt - uf[:, :, gi])
    t = jnp.stack(pooled, axis=2).astype(h.dtype)
    y = jnp.einsum('blgc,gcd->blgd', t, w_grp).reshape(B, L, D_INNER)
    y = y * scale * jax.nn.silu(z)
    return y @ w_out


def gla_mixer(h, w_in, w_gate2, b_gate, head_norm, w_out):
    B, L, _ = h.shape
    proj = h @ w_in
    q, k, v, z, glr = jnp.split(
        proj, [GLA_DK_TOTAL, 2 * GLA_DK_TOTAL, 2 * GLA_DK_TOTAL + D_INNER, 2 * GLA_DK_TOTAL + 2 * D_INNER],
        axis=-1)
    log_a = jax.nn.log_sigmoid((glr @ w_gate2 + b_gate).astype(jnp.float32)) / GATE_TAU

    pad = (-N_META) % CHUNK
    Lp = L + pad
    n_chunks = Lp // CHUNK

    def to_chunks(t, d):
        t = t.astype(jnp.float32).reshape(B, L, GLA_HEADS, d)
        t = jnp.pad(t, ((0, 0), (pad, 0), (0, 0), (0, 0)))
        return t.reshape(B, n_chunks, CHUNK, GLA_HEADS, d).transpose(1, 0, 3, 2, 4)

    qc = to_chunks(q, GLA_DK) * (GLA_DK ** -0.5)
    kc = to_chunks(k, GLA_DK)
    vc = to_chunks(v, GLA_DV)
    lac = to_chunks(log_a, GLA_DK)
    mask = jnp.tril(jnp.ones((CHUNK, CHUNK), dtype=bool))

    def step(S, inp):
        qb, kb, vb, lab = inp
        cum = jnp.cumsum(lab, axis=2)
        qe = qb * jnp.exp(cum)
        ke = kb * jnp.exp(-cum)
        att = jnp.where(mask, jnp.einsum('bhtd,bhsd->bhts', qe, ke), 0.0)
        o = jnp.einsum('bhts,bhse->bhte', att, vb) + jnp.einsum('bhtd,bhde->bhte', qe, S)
        g_tot = cum[:, :, -1]
        kd = kb * jnp.exp(g_tot[:, :, None, :] - cum)
        S_new = jnp.exp(g_tot)[..., None] * S + jnp.einsum('bhsd,bhse->bhde', kd, vb)
        return S_new, o

    S0 = jnp.zeros((B, GLA_HEADS, GLA_DK, GLA_DV), jnp.float32)
    _, o = lax.scan(step, S0, (qc, kc, vc, lac))
    o = o.transpose(1, 0, 3, 2, 4).reshape(B, Lp, GLA_HEADS, GLA_DV)[:, pad:]
    o = o * lax.rsqrt(jnp.mean(o * o, axis=-1, keepdims=True) + EPS)
    o = o.reshape(B, L, D_INNER) * head_norm.astype(jnp.float32)
    y = o.astype(h.dtype) * jax.nn.silu(z)
    return y @ w_out


def setup_inputs(seed: int = 0) -> dict:
    key = jax.random.key(seed)
    ks = jax.random.split(key, 16)
    f32 = jnp.float32
    nrm = lambda k, shape, s: jax.random.normal(k, shape, f32) * s
    return {
        "x": nrm(ks[0], (BATCH, SEQ, D_MODEL), 1.0),
        "meta": nrm(ks[1], (N_META, D_MODEL), 1.0),
        "final_norm": 1.0 + nrm(ks[2], (D_MODEL,), 0.02),
        "pool_norm": 1.0 + nrm(ks[3], (N_POOL_LAYERS, D_MODEL), 0.02),
        "pool_w_in": nrm(ks[4], (N_POOL_LAYERS, D_MODEL, 2 * D_INNER), D_MODEL ** -0.5),
        "pool_w_grp": nrm(ks[5], (N_POOL_LAYERS, N_POOL_GROUPS, POOL_GROUP, POOL_GROUP), POOL_GROUP ** -0.5),
        "pool_scale": 1.0 + nrm(ks[6], (N_POOL_LAYERS, D_INNER), 0.02),
        "pool_w_out": nrm(ks[7], (N_POOL_LAYERS, D_INNER, D_MODEL), D_INNER ** -0.5),
        "gla_norm": 1.0 + nrm(ks[8], (N_GLA_LAYERS, D_MODEL), 0.02),
        "gla_w_in": nrm(ks[9], (N_GLA_LAYERS, D_MODEL, GLA_IN), D_MODEL ** -0.5),
        "gla_w_gate2": nrm(ks[10], (N_GLA_LAYERS, GATE_RANK, GLA_DK_TOTAL), GATE_RANK ** -0.5),
        "gla_b_gate": nrm(ks[11], (N_GLA_LAYERS, GLA_DK_TOTAL), 0.1),
        "gla_head_norm": 1.0 + nrm(ks[12], (N_GLA_LAYERS, D_INNER), 0.02),
        "gla_w_out": nrm(ks[13], (N_GLA_LAYERS, D_INNER, D_MODEL), D_INNER ** -0.5),
    }


def reference(x, meta, final_norm, pool_norm, pool_w_in, pool_w_grp, pool_scale, pool_w_out,
              gla_norm, gla_w_in, gla_w_gate2, gla_b_gate, gla_head_norm, gla_w_out):
    B = x.shape[0]
    h = jnp.concatenate([jnp.broadcast_to(meta.astype(x.dtype)[None], (B, N_META, D_MODEL)), x], axis=1)
    for i in range(DEPTH):
        j = i // 2
        if i % 2 == 0:
            h = h + pool_mixer(rmsnorm(h, pool_norm[j]), pool_w_in[j], pool_w_grp[j],
                               pool_scale[j], pool_w_out[j])
        else:
            h = h + gla_mixer(rmsnorm(h, gla_norm[j]), gla_w_in[j], gla_w_gate2[j],
                              gla_b_gate[j], gla_head_norm[j], gla_w_out[j])
    return rmsnorm(h, final_norm)[:, N_META:]
```

```cpp
#include <hip/hip_runtime.h>
#include <hip/hip_cooperative_groups.h>
#include <cstdio>
namespace cg = cooperative_groups;

typedef unsigned short u16;
typedef unsigned int u32;
using bf16x8 = __attribute__((ext_vector_type(8))) short;
using f32x4 = __attribute__((ext_vector_type(4))) float;
#define DI __device__ __forceinline__

constexpr int NT = 512;
constexpr int DM = 1024, NB = 8, SEQ = 2048, NMETA = 16, TT = SEQ + NMETA, MR = NB * TT;
constexpr int DIN = 2048;
constexpr int NCH = 33, PADC = 48;
constexpr float EPS = 1e-6f;

constexpr size_t UNIT = (size_t)MR * 1024 * 2;
constexpr size_t H_OFF = 0;
constexpr size_t XN_OFF = 2 * UNIT;
constexpr size_t A_OFF = 3 * UNIT;
constexpr size_t B_OFF = 5 * UNIT;
constexpr size_t GLR_OFF = 7 * UNIT;
constexpr size_t G_OFF = GLR_OFF + (size_t)MR * 16 * 4;
constexpr size_t SSQ_OFF = G_OFF + (size_t)NB * NCH * 1024 * 4;
constexpr size_t WS_END = SSQ_OFF + (size_t)MR * 4 * 16 * 4;

constexpr size_t PW_SZ = 7340032, GW_SZ = 8519680;
constexpr size_t PW_IN = 0, PW_GRP = 4194304, PW_OUT = 5242880;
constexpr size_t GW_BASE = 2 * PW_SZ;
constexpr size_t GW_A = 0, GW_Z = 4325376, GW_OUT = 6422528;

constexpr int LDS_BYTES = 157696;

struct Params {
  const float *x, *meta, *final_norm, *pool_norm, *pool_w_in, *pool_w_grp, *pool_scale, *pool_w_out,
      *gla_norm, *gla_w_in, *gla_w_gate2, *gla_b_gate, *gla_head_norm, *gla_w_out;
  float* out;
  unsigned char* ws;
};

extern __shared__ __attribute__((aligned(16))) unsigned char smem[];

DI u16 f2bf(float x) { u32 u = __float_as_uint(x); u += 0x7fffu + ((u >> 16) & 1u); return (u16)(u >> 16); }
DI float bf2f(u16 v) { return __uint_as_float(((u32)v) << 16); }
DI u32 pack2(float a, float b) { return (u32)f2bf(a) | ((u32)f2bf(b) << 16); }
DI float bflo(u32 w) { return __uint_as_float(w << 16); }
DI float bfhi(u32 w) { return __uint_as_float(w & 0xffff0000u); }
DI float wave_sum(float v) {
#pragma unroll
  for (int o = 32; o > 0; o >>= 1) v += __shfl_xor(v, o);
  return v;
}
DI float silu(float z) { return z / (1.f + __expf(-z)); }

DI void cvt_job(const float* __restrict__ src, int ld, int coff, int K, int nvalid, int npad, u16* __restrict__ dst) {
  float* tile = (float*)smem;
  const int tid = threadIdx.x;
  const int tk = K / 64, tn = npad / 64;
  const int c = tid & 63, rg = tid >> 6;
  for (int t = blockIdx.x; t < tk * tn; t += gridDim.x) {
    const int k0 = (t % tk) * 64, n0 = (t / tk) * 64;
#pragma unroll
    for (int i = 0; i < 8; ++i) {
      const int k = rg + i * 8;
      const int n = n0 + c;
      float v = 0.f;
      if (n < nvalid) v = src[(size_t)(k0 + k) * ld + coff + n];
      tile[k * 65 + c] = v;
    }
    __syncthreads();
#pragma unroll
    for (int i = 0; i < 8; ++i) {
      const int n = rg + i * 8;
      dst[(size_t)(n0 + n) * K + k0 + c] = f2bf(tile[c * 65 + n]);
    }
    __syncthreads();
  }
}

DI void cvt_phase(const Params& p) {
  u16* W = (u16*)p.out;
  for (int job = 0; job < 20; ++job) {
    if (job < 12) {
      const int j = job / 6, s = job % 6;
      u16* base = W + (size_t)j * PW_SZ;
      if (s == 0) cvt_job(p.pool_w_in + (size_t)j * 1024 * 4096, 4096, 0, 1024, 4096, 4096, base + PW_IN);
      else if (s < 5) cvt_job(p.pool_w_grp + (size_t)(j * 4 + (s - 1)) * 512 * 512, 512, 0, 512, 512, 512, base + PW_GRP + (size_t)(s - 1) * 512 * 512);
      else cvt_job(p.pool_w_out + (size_t)j * 2048 * 1024, 1024, 0, 2048, 1024, 1024, base + PW_OUT);
    } else {
      const int jj = job - 12, j = jj / 4, s = jj % 4;
      u16* base = W + GW_BASE + (size_t)j * GW_SZ;
      const float* win = p.gla_w_in + (size_t)j * 1024 * 6160;
      if (s == 0) cvt_job(win, 6160, 0, 1024, 4096, 4096, base + GW_A);
      else if (s == 1) cvt_job(win, 6160, 6144, 1024, 16, 128, base + GW_A + (size_t)4096 * 1024);
      else if (s == 2) cvt_job(win, 6160, 4096, 1024, 2048, 2048, base + GW_Z);
      else cvt_job(p.gla_w_out + (size_t)j * 2048 * 1024, 1024, 0, 2048, 1024, 1024, base + GW_OUT);
    }
  }
}

DI void norm_phase(const Params& p, int mode, const float* __restrict__ g) {
  const int tid = threadIdx.x, lane = tid & 63, wid = tid >> 6;
  float* h = (float*)(p.ws + H_OFF);
  u16* xn = (u16*)(p.ws + XN_OFF);
  float4 gv[4];
#pragma unroll
  for (int i = 0; i < 4; ++i) gv[i] = *(const float4*)(g + i * 256 + lane * 4);
  for (int r = blockIdx.x * 8 + wid; r < MR; r += gridDim.x * 8) {
    const int b = r / TT, t = r - b * TT;
    if (mode == 2 && t < NMETA) continue;
    const float* src;
    if (mode == 0) src = (t < NMETA) ? (p.meta + (size_t)t * 1024) : (p.x + ((size_t)b * SEQ + (t - NMETA)) * 1024);
    else src = h + (size_t)r * 1024;
    float4 v[4];
    float ss = 0.f;
#pragma unroll
    for (int i = 0; i < 4; ++i) {
      v[i] = *(const float4*)(src + i * 256 + lane * 4);
      ss += v[i].x * v[i].x + v[i].y * v[i].y + v[i].z * v[i].z + v[i].w * v[i].w;
    }
    ss = wave_sum(ss);
    const float rinv = rsqrtf(ss * (1.f / 1024.f) + EPS);
    if (mode == 0) {
#pragma unroll
      for (int i = 0; i < 4; ++i) *(float4*)(h + (size_t)r * 1024 + i * 256 + lane * 4) = v[i];
    }
    if (mode < 2) {
#pragma unroll
      for (int i = 0; i < 4; ++i) {
        uint2 o;
        o.x = pack2(v[i].x * rinv * gv[i].x, v[i].y * rinv * gv[i].y);
        o.y = pack2(v[i].z * rinv * gv[i].z, v[i].w * rinv * gv[i].w);
        *(uint2*)(xn + (size_t)r * 1024 + i * 256 + lane * 4) = o;
      }
    } else {
      float* dst = p.out + ((size_t)b * SEQ + (t - NMETA)) * 1024;
#pragma unroll
      for (int i = 0; i < 4; ++i) {
        float4 o;
        o.x = v[i].x * rinv * gv[i].x; o.y = v[i].y * rinv * gv[i].y;
        o.z = v[i].z * rinv * gv[i].z; o.w = v[i].w * rinv * gv[i].w;
        *(float4*)(dst + i * 256 + lane * 4) = o;
      }
    }
  }
}

template <int NF>
DI void gemm_stage(const u16* __restrict__ A, int lda, const u16* __restrict__ Bt, int K, int m0, int n0, int kcol, int bkcol, int buf) {
  constexpr int STAGE = 16384 + NF * 64 * 128;
  const int tid = threadIdx.x;
  unsigned char* sa = smem + buf * STAGE;
  unsigned char* sb = sa + 16384;
#pragma unroll
  for (int rnd = 0; rnd < 2; ++rnd) {
    const int pidx = rnd * 512 + tid;
    const int r = pidx >> 3, cp = pidx & 7;
    const int kc = cp ^ ((r >> 1) & 7);
    const u16* gp = A + (size_t)(m0 + r) * lda + kcol + kc * 8;
    __builtin_amdgcn_global_load_lds((const u32*)gp, (__attribute__((address_space(3))) u32*)(sa + pidx * 16), 16, 0, 0);
  }
#pragma unroll
  for (int rnd = 0; rnd < NF; ++rnd) {
    const int pidx = rnd * 512 + tid;
    const int r = pidx >> 3, cp = pidx & 7;
    const int kc = cp ^ ((r >> 1) & 7);
    const u16* gp = Bt + (size_t)(n0 + r) * K + bkcol + kc * 8;
    __builtin_amdgcn_global_load_lds((const u32*)gp, (__attribute__((address_space(3))) u32*)(sb + pidx * 16), 16, 0, 0);
  }
}

template <int NF, class Epi>
DI void gemm_phase(const u16* __restrict__ A, int lda, const u16* __restrict__ Bt, int K, int ntn, bool grouped, const Epi& epi) {
  constexpr int STAGE = 16384 + NF * 64 * 128;
  constexpr int BN = 64 * NF;
  const int tid = threadIdx.x, lane = tid & 63, wid = tid >> 6;
  const int wr = wid >> 2, wc = wid & 3, fr = lane & 15, fq = lane >> 4;
  const int ntiles = (MR / 128) * ntn;
  const int nk = K / 64;
  for (int t = blockIdx.x; t < ntiles; t += gridDim.x) {
    const int mt = t / ntn, nt = t - mt * ntn;
    const int m0 = mt * 128, n0 = nt * BN;
    const int akoff = grouped ? ((n0 >> 9) << 9) : 0;
    f32x4 acc[4][NF];
#pragma unroll
    for (int i = 0; i < 4; ++i)
#pragma unroll
      for (int j = 0; j < NF; ++j) acc[i][j] = (f32x4){0.f, 0.f, 0.f, 0.f};
    gemm_stage<NF>(A, lda, Bt, K, m0, n0, akoff, 0, 0);
    for (int kt = 0; kt < nk; ++kt) {
      asm volatile("s_waitcnt vmcnt(0)" ::: "memory");
      __syncthreads();
      if (kt + 1 < nk) gemm_stage<NF>(A, lda, Bt, K, m0, n0, akoff + (kt + 1) * 64, (kt + 1) * 64, (kt + 1) & 1);
      const unsigned char* sa = smem + (kt & 1) * STAGE;
      const unsigned char* sb = sa + 16384;
#pragma unroll
      for (int ks = 0; ks < 2; ++ks) {
        bf16x8 af[4], bfr[NF];
#pragma unroll
        for (int mi = 0; mi < 4; ++mi) {
          const int row = wr * 64 + mi * 16 + fr;
          const int kc = (ks * 4 + fq) ^ ((row >> 1) & 7);
          af[mi] = *(const bf16x8*)(sa + row * 128 + kc * 16);
        }
#pragma unroll
        for (int ni = 0; ni < NF; ++ni) {
          const int row = wc * (NF * 16) + ni * 16 + fr;
          const int kc = (ks * 4 + fq) ^ ((row >> 1) & 7);
          bfr[ni] = *(const bf16x8*)(sb + row * 128 + kc * 16);
        }
#pragma unroll
        for (int mi = 0; mi < 4; ++mi)
#pragma unroll
          for (int ni = 0; ni < NF; ++ni)
            acc[mi][ni] = __builtin_amdgcn_mfma_f32_16x16x32_bf16(bfr[ni], af[mi], acc[mi][ni], 0, 0, 0);
      }
    }
#pragma unroll
    for (int mi = 0; mi < 4; ++mi)
#pragma unroll
      for (int ni = 0; ni < NF; ++ni)
        epi(m0 + wr * 64 + mi * 16 + fr, n0 + wc * (NF * 16) + ni * 16 + fq * 4, acc[mi][ni]);
    __syncthreads();
  }
}

struct EpiStoreBf16 {
  u16* out; int ld;
  DI void operator()(int row, int col, f32x4 v) const {
    uint2 o; o.x = pack2(v[0], v[1]); o.y = pack2(v[2], v[3]);
    *(uint2*)(out + (size_t)row * ld + col) = o;
  }
};
struct EpiScaleBf16 {
  u16* out; const float* scale;
  DI void operator()(int row, int col, f32x4 v) const {
    const float4 s = *(const float4*)(scale + col);
    uint2 o; o.x = pack2(v[0] * s.x, v[1] * s.y); o.y = pack2(v[2] * s.z, v[3] * s.w);
    *(uint2*)(out + (size_t)row * DIN + col) = o;
  }
};
struct EpiGateInplace {
  u16* y;
  DI void operator()(int row, int col, f32x4 v) const {
    uint2* ptr = (uint2*)(y + (size_t)row * DIN + col);
    const uint2 yv = *ptr;
    uint2 o;
    o.x = pack2(bflo(yv.x) * silu(v[0]), bfhi(yv.x) * silu(v[1]));
    o.y = pack2(bflo(yv.y) * silu(v[2]), bfhi(yv.y) * silu(v[3]));
    *ptr = o;
  }
};
struct EpiResidual {
  float* h;
  DI void operator()(int row, int col, f32x4 v) const {
    float4* ptr = (float4*)(h + (size_t)row * DM + col);
    float4 hv = *ptr;
    hv.x += v[0]; hv.y += v[1]; hv.z += v[2]; hv.w += v[3];
    *ptr = hv;
  }
};
struct EpiQKV {
  u16 *q, *k, *v; float* glr;
  DI void operator()(int row, int col, f32x4 a) const {
    if (col < 4096) {
      uint2 o; o.x = pack2(a[0], a[1]); o.y = pack2(a[2], a[3]);
      u16* dst;
      if (col < 1024) dst = q + (size_t)row * 1024 + col;
      else if (col < 2048) dst = k + (size_t)row * 1024 + (col - 1024);
      else dst = v + (size_t)row * DIN + (col - 2048);
      *(uint2*)dst = o;
    } else if (col < 4112) {
      float4 o; o.x = a[0]; o.y = a[1]; o.z = a[2]; o.w = a[3];
      *(float4*)(glr + (size_t)row * 16 + (col - 4096)) = o;
    }
  }
};
struct EpiGlaGate {
  u16* o; const float* ssq; const float* hn;
  DI void operator()(int row, int col, f32x4 z) const {
    const int head = col >> 9;
    const float4* sp = (const float4*)(ssq + ((size_t)row * 4 + head) * 16);
    float s = 0.f;
#pragma unroll
    for (int i = 0; i < 4; ++i) { const float4 t = sp[i]; s += t.x + t.y + t.z + t.w; }
    const float rinv = rsqrtf(s * (1.f / 512.f) + EPS);
    const float4 g = *(const float4*)(hn + col);
    uint2* ptr = (uint2*)(o + (size_t)row * DIN + col);
    const uint2 ov = *ptr;
    uint2 r;
    r.x = pack2(bflo(ov.x) * rinv * g.x * silu(z[0]), bfhi(ov.x) * rinv * g.y * silu(z[1]));
    r.y = pack2(bflo(ov.y) * rinv * g.z * silu(z[2]), bfhi(ov.y) * rinv * g.w * silu(z[3]));
    *ptr = r;
  }
};

DI void pool_phase(const u16* __restrict__ U, u16* __restrict__ Tb) {
  const int total = (MR / 16) * 256;
  for (int it = blockIdx.x * NT + threadIdx.x; it < total; it += gridDim.x * NT) {
    const int cgp = it & 255, run = it >> 8;
    const int c0 = cgp * 8;
    const int w = 2 << (c0 >> 9);
    const int b = run / 129, p0 = (run - b * 129) * 16;
    const size_t rbase = (size_t)b * TT + p0;
    float sum[8];
#pragma unroll
    for (int e = 0; e < 8; ++e) sum[e] = 0.f;
    if (p0 > 0) {
      for (int s = 1; s <= w; ++s) {
        const uint4 v = *(const uint4*)(U + (rbase - s) * DIN + c0);
        sum[0] += bflo(v.x); sum[1] += bfhi(v.x); sum[2] += bflo(v.y); sum[3] += bfhi(v.y);
        sum[4] += bflo(v.z); sum[5] += bfhi(v.z); sum[6] += bflo(v.w); sum[7] += bfhi(v.w);
      }
    }
    for (int i = 0; i < 16; ++i) {
      const int pp = p0 + i;
      const uint4 v = *(const uint4*)(U + (rbase + i) * DIN + c0);
      float cur[8] = {bflo(v.x), bfhi(v.x), bflo(v.y), bfhi(v.y), bflo(v.z), bfhi(v.z), bflo(v.w), bfhi(v.w)};
      if (pp - w >= 0) {
        const uint4 o = *(const uint4*)(U + (rbase + i - w) * DIN + c0);
        sum[0] -= bflo(o.x); sum[1] -= bfhi(o.x); sum[2] -= bflo(o.y); sum[3] -= bfhi(o.y);
        sum[4] -= bflo(o.z); sum[5] -= bfhi(o.z); sum[6] -= bflo(o.w); sum[7] -= bfhi(o.w);
      }
#pragma unroll
      for (int e = 0; e < 8; ++e) sum[e] += cur[e];
      const float inv = 1.f / (float)min(pp + 1, w);
      uint4 r;
      r.x = pack2(sum[0] * inv - cur[0], sum[1] * inv - cur[1]);
      r.y = pack2(sum[2] * inv - cur[2], sum[3] * inv - cur[3]);
      r.z = pack2(sum[4] * inv - cur[4], sum[5] * inv - cur[5]);
      r.w = pack2(sum[6] * inv - cur[6], sum[7] * inv - cur[7]);
      *(uint4*)(Tb + (rbase + i) * DIN + c0) = r;
    }
  }
}

DI float logsig(float x) { return fminf(x, 0.f) - log1pf(__expf(-fabsf(x))); }

DI void gla_prep_phase(const Params& p, int j) {
  u16* Q = (u16*)(p.ws + A_OFF);
  u16* Kb = (u16*)(p.ws + A_OFF + UNIT);
  const float* GLR = (const float*)(p.ws + GLR_OFF);
  float* G = (float*)(p.ws + G_OFF);
  const float* w2 = p.gla_w_gate2 + (size_t)j * 16 * 1024;
  const float* bg = p.gla_b_gate + (size_t)j * 1024;
  const int lane = threadIdx.x & 63;
  const int wid = __builtin_amdgcn_readfirstlane(threadIdx.x >> 6);
  for (int it = blockIdx.x * 8 + wid; it < NB * NCH * 8; it += gridDim.x * 8) {
    const int cb = it & 7, bc = it >> 3;
    const int c = bc % NCH, b = bc / NCH;
    const int col = cb * 128 + lane * 2;
    float wa[16], wb[16];
#pragma unroll
    for (int k = 0; k < 16; ++k) { const float2 t = *(const float2*)(w2 + k * 1024 + col); wa[k] = t.x; wb[k] = t.y; }
    const float2 bb = *(const float2*)(bg + col);
    float cuma = 0.f, cumb = 0.f;
    const int i0 = (c == 0) ? PADC : 0;
    for (int i = i0; i < 64; ++i) {
      const size_t row = (size_t)b * TT + (c * 64 - PADC + i);
      const float4* gp = (const float4*)(GLR + row * 16);
      const float4 g0 = gp[0], g1 = gp[1], g2 = gp[2], g3 = gp[3];
      const float gl[16] = {g0.x, g0.y, g0.z, g0.w, g1.x, g1.y, g1.z, g1.w, g2.x, g2.y, g2.z, g2.w, g3.x, g3.y, g3.z, g3.w};
      float xa = bb.x, xb = bb.y;
#pragma unroll
      for (int k = 0; k < 16; ++k) { xa += gl[k] * wa[k]; xb += gl[k] * wb[k]; }
      cuma += logsig(xa) * (1.f / 16.f);
      cumb += logsig(xb) * (1.f / 16.f);
      u32* qp = (u32*)(Q + row * 1024 + col);
      u32* kp = (u32*)(Kb + row * 1024 + col);
      const u32 qv = *qp, kv = *kp;
      const float ea = __expf(cuma), eb = __expf(cumb);
      *qp = pack2(bflo(qv) * ea * 0.0625f, bfhi(qv) * eb * 0.0625f);
      *kp = pack2(bflo(kv) / ea, bfhi(kv) / eb);
    }
    float2 go; go.x = __expf(cuma); go.y = __expf(cumb);
    *(float2*)(G + ((size_t)(b * NCH + c)) * 1024 + col) = go;
  }
}

constexpr int L_QE = 0, L_KE = 33792, L_ST = 67584, L_KET = 101376, L_VT = 138240, L_ATT = 147456, L_GL = 156672;
constexpr int RS_W = 528, RS_N = 144;

DI void gla_scan_phase(const Params& p) {
  const u16* Q = (const u16*)(p.ws + A_OFF);
  const u16* Kb = (const u16*)(p.ws + A_OFF + UNIT);
  u16* V = (u16*)(p.ws + B_OFF);
  const float* G = (const float*)(p.ws + G_OFF);
  float* SSQ = (float*)(p.ws + SSQ_OFF);
  const int tid = threadIdx.x, lane = tid & 63, wid = tid >> 6, fr = lane & 15, fq = lane >> 4;
  for (int item = blockIdx.x; item < 256; item += gridDim.x) {
    const int b = item >> 5, hh = (item >> 3) & 3, eb = item & 7;
    f32x4 S[2][4];
#pragma unroll
    for (int x = 0; x < 2; ++x)
#pragma unroll
      for (int e = 0; e < 4; ++e) S[x][e] = (f32x4){0.f, 0.f, 0.f, 0.f};
    for (int c = 0; c < NCH; ++c) {
      {
#pragma unroll
        for (int rr = 0; rr < 4; ++rr) {
          const int pidx = tid + 512 * rr;
          const int i = pidx >> 5, cc = pidx & 31;
          const int t = c * 64 - PADC + i;
          uint4 qv = make_uint4(0, 0, 0, 0), kv = make_uint4(0, 0, 0, 0);
          if (t >= 0) {
            const size_t off = ((size_t)b * TT + t) * 1024 + hh * 256 + cc * 8;
            qv = *(const uint4*)(Q + off);
            kv = *(const uint4*)(Kb + off);
          }
          *(uint4*)(smem + L_QE + i * RS_W + cc * 16) = qv;
          *(uint4*)(smem + L_KE + i * RS_W + cc * 16) = kv;
        }
        {
          const int i = tid >> 3, cc = tid & 7;
          const int t = c * 64 - PADC + i;
          uint4 vv = make_uint4(0, 0, 0, 0);
          if (t >= 0) vv = *(const uint4*)(V + ((size_t)b * TT + t) * DIN + hh * 512 + eb * 64 + cc * 8);
          *(uint4*)(smem + L_ATT + i * RS_N + cc * 16) = vv;
        }
        if (tid < 256) *(float*)(smem + L_GL + tid * 4) = G[((size_t)(b * NCH + c)) * 1024 + hh * 256 + tid];
#pragma unroll
        for (int x = 0; x < 2; ++x)
#pragma unroll
          for (int e = 0; e < 4; ++e) {
            uint2 o; o.x = pack2(S[x][e][0], S[x][e][1]); o.y = pack2(S[x][e][2], S[x][e][3]);
            *(uint2*)(smem + L_ST + (e * 16 + fr) * RS_W + ((wid * 2 + x) * 16 + fq * 4) * 2) = o;
          }
      }
      __syncthreads();
      {
        const int d = tid & 255, ih = tid >> 8;
#pragma unroll
        for (int i4 = 0; i4 < 8; ++i4) {
          const int i = ih * 32 + i4 * 4;
          const u16 a0 = *(const u16*)(smem + L_KE + (i + 0) * RS_W + d * 2);
          const u16 a1 = *(const u16*)(smem + L_KE + (i + 1) * RS_W + d * 2);
          const u16 a2 = *(const u16*)(smem + L_KE + (i + 2) * RS_W + d * 2);
          const u16 a3 = *(const u16*)(smem + L_KE + (i + 3) * RS_W + d * 2);
          uint2 o; o.x = (u32)a0 | ((u32)a1 << 16); o.y = (u32)a2 | ((u32)a3 << 16);
          *(uint2*)(smem + L_KET + d * RS_N + i * 2) = o;
        }
        const int e = tid & 63, ig = tid >> 6;
        {
          const int i = ig * 8;
          u16 a[8];
#pragma unroll
          for (int q = 0; q < 8; ++q) a[q] = *(const u16*)(smem + L_ATT + (i + q) * RS_N + e * 2);
          uint4 o;
          o.x = (u32)a[0] | ((u32)a[1] << 16); o.y = (u32)a[2] | ((u32)a[3] << 16);
          o.z = (u32)a[4] | ((u32)a[5] << 16); o.w = (u32)a[6] | ((u32)a[7] << 16);
          *(uint4*)(smem + L_VT + e * RS_N + i * 2) = o;
        }
      }
      __syncthreads();
      {
#pragma unroll
        for (int x = 0; x < 2; ++x) {
          const int f = wid * 2 + x, sf = f >> 2, tf = f & 3;
          f32x4 acc = (f32x4){0.f, 0.f, 0.f, 0.f};
          if (sf <= tf) {
#pragma unroll
            for (int ks = 0; ks < 8; ++ks) {
              const bf16x8 ka = *(const bf16x8*)(smem + L_KE + (sf * 16 + fr) * RS_W + (ks * 4 + fq) * 16);
              const bf16x8 qb = *(const bf16x8*)(smem + L_QE + (tf * 16 + fr) * RS_W + (ks * 4 + fq) * 16);
              acc = __builtin_amdgcn_mfma_f32_16x16x32_bf16(ka, qb, acc, 0, 0, 0);
            }
            const int tcol = tf * 16 + fr;
#pragma unroll
            for (int jj = 0; jj < 4; ++jj) if (sf * 16 + fq * 4 + jj > tcol) acc[jj] = 0.f;
          }
          uint2 o; o.x = pack2(acc[0], acc[1]); o.y = pack2(acc[2], acc[3]);
          *(uint2*)(smem + L_ATT + (tf * 16 + fr) * RS_N + (sf * 16 + fq * 4) * 2) = o;
        }
#pragma unroll
        for (int ks = 0; ks < 2; ++ks) {
          bf16x8 ka[2], vb[4];
#pragma unroll
          for (int x = 0; x < 2; ++x) ka[x] = *(const bf16x8*)(smem + L_KET + ((wid * 2 + x) * 16 + fr) * RS_N + (ks * 4 + fq) * 16);
#pragma unroll
          for (int e = 0; e < 4; ++e) vb[e] = *(const bf16x8*)(smem + L_VT + (e * 16 + fr) * RS_N + (ks * 4 + fq) * 16);
#pragma unroll
          for (int x = 0; x < 2; ++x)
#pragma unroll
            for (int e = 0; e < 4; ++e) S[x][e] = __builtin_amdgcn_mfma_f32_16x16x32_bf16(ka[x], vb[e], S[x][e], 0, 0, 0);
        }
#pragma unroll
        for (int x = 0; x < 2; ++x) {
          const float4 gv = *(const float4*)(smem + L_GL + ((wid * 2 + x) * 16 + fq * 4) * 4);
#pragma unroll
          for (int e = 0; e < 4; ++e) { S[x][e][0] *= gv.x; S[x][e][1] *= gv.y; S[x][e][2] *= gv.z; S[x][e][3] *= gv.w; }
        }
      }
      __syncthreads();
      {
        const int tf = wid >> 1;
        f32x4 oacc[2];
        oacc[0] = (f32x4){0.f, 0.f, 0.f, 0.f}; oacc[1] = oacc[0];
#pragma unroll
        for (int ks = 0; ks < 2; ++ks) {
          const bf16x8 ab = *(const bf16x8*)(smem + L_ATT + (tf * 16 + fr) * RS_N + (ks * 4 + fq) * 16);
#pragma unroll
          for (int y = 0; y < 2; ++y) {
            const int ef = (wid & 1) * 2 + y;
            const bf16x8 va = *(const bf16x8*)(smem + L_VT + (ef * 16 + fr) * RS_N + (ks * 4 + fq) * 16);
            oacc[y] = __builtin_amdgcn_mfma_f32_16x16x32_bf16(va, ab, oacc[y], 0, 0, 0);
          }
        }
#pragma unroll
        for (int ks = 0; ks < 8; ++ks) {
          const bf16x8 qb = *(const bf16x8*)(smem + L_QE + (tf * 16 + fr) * RS_W + (ks * 4 + fq) * 16);
#pragma unroll
          for (int y = 0; y < 2; ++y) {
            const int ef = (wid & 1) * 2 + y;
            const bf16x8 sa = *(const bf16x8*)(smem + L_ST + (ef * 16 + fr) * RS_W + (ks * 4 + fq) * 16);
            oacc[y] = __builtin_amdgcn_mfma_f32_16x16x32_bf16(sa, qb, oacc[y], 0, 0, 0);
          }
        }
        const int i = tf * 16 + fr;
        const int t = c * 64 - PADC + i;
        float ss = 0.f;
#pragma unroll
        for (int y = 0; y < 2; ++y)
#pragma unroll
          for (int jj = 0; jj < 4; ++jj) ss += oacc[y][jj] * oacc[y][jj];
        ss += __shfl_xor(ss, 16);
        ss += __shfl_xor(ss, 32);
        if (t >= 0) {
          const size_t row = (size_t)b * TT + t;
#pragma unroll
          for (int y = 0; y < 2; ++y) {
            const int ef = (wid & 1) * 2 + y;
            uint2 o; o.x = pack2(oacc[y][0], oacc[y][1]); o.y = pack2(oacc[y][2], oacc[y][3]);
            *(uint2*)(V + row * DIN + hh * 512 + eb * 64 + ef * 16 + fq * 4) = o;
          }
          if (fq == 0) SSQ[(row * 4 + hh) * 16 + eb * 2 + (wid & 1)] = ss;
        }
      }
      __syncthreads();
    }
  }
}

__global__ void __launch_bounds__(NT) trunk_megakernel(Params p) {
  cg::grid_group grid = cg::this_grid();
  u16* W = (u16*)p.out;
  float* h = (float*)(p.ws + H_OFF);
  const u16* xn = (const u16*)(p.ws + XN_OFF);
  u16* bufA = (u16*)(p.ws + A_OFF);
  u16* bufB = (u16*)(p.ws + B_OFF);

  cvt_phase(p);
  norm_phase(p, 0, p.pool_norm);
  grid.sync();

  for (int layer = 0; layer < 4; ++layer) {
    const int j = layer >> 1;
    if ((layer & 1) == 0) {
      const u16* Wl = W + (size_t)j * PW_SZ;
      gemm_phase<2>(xn, 1024, Wl + PW_IN, 1024, 16, false, EpiStoreBf16{bufA, DIN});
      grid.sync();
      pool_phase(bufA, bufB);
      grid.sync();
      gemm_phase<2>(bufB, DIN, Wl + PW_GRP, 512, 16, true, EpiScaleBf16{bufA, p.pool_scale + (size_t)j * DIN});
      grid.sync();
      gemm_phase<2>(xn, 1024, Wl + PW_IN + (size_t)2048 * 1024, 1024, 16, false, EpiGateInplace{bufA});
      grid.sync();
      gemm_phase<2>(bufA, DIN, Wl + PW_OUT, 2048, 8, false, EpiResidual{h});
      grid.sync();
    } else {
      const u16* Wl = W + GW_BASE + (size_t)j * GW_SZ;
      gemm_phase<2>(xn, 1024, Wl + GW_A, 1024, 33, false, EpiQKV{bufA, bufA + (size_t)MR * 1024, bufB, (float*)(p.ws + GLR_OFF)});
      grid.sync();
      gla_prep_phase(p, j);
      grid.sync();
      gla_scan_phase(p);
      grid.sync();
      gemm_phase<2>(xn, 1024, Wl + GW_Z, 1024, 16, false, EpiGlaGate{bufB, (const float*)(p.ws + SSQ_OFF), p.gla_head_norm + (size_t)j * DIN});
      grid.sync();
      gemm_phase<2>(bufB, DIN, Wl + GW_OUT, 2048, 8, false, EpiResidual{h});
      grid.sync();
    }
    if (layer == 0 || layer == 2) norm_phase(p, 1, p.gla_norm + (size_t)j * DM);
    else if (layer == 1) norm_phase(p, 1, p.pool_norm + (size_t)1 * DM);
    else norm_phase(p, 2, p.final_norm);
    if (layer < 3) grid.sync();
  }
}

extern "C" void kernel_launch(void* const* d_in, const int* in_sizes, int n_in, void* d_out, int out_size, void* d_ws,
                              size_t ws_size, hipStream_t stream) {
  static int grid_blocks = 0;
  if (grid_blocks == 0) {
    if (ws_size < WS_END) { fprintf(stderr, "kernel_launch: workspace too small (%zu < %zu)\n", ws_size, (size_t)WS_END); grid_blocks = -1; return; }
    int dev = 0, cus = 0, per_cu = 0;
    hipGetDevice(&dev);
    hipDeviceGetAttribute(&cus, hipDeviceAttributeMultiprocessorCount, dev);
    if (hipFuncSetAttribute((const void*)trunk_megakernel, hipFuncAttributeMaxDynamicSharedMemorySize, LDS_BYTES) != hipSuccess) {
      fprintf(stderr, "kernel_launch: hipFuncSetAttribute failed\n"); grid_blocks = -1; return;
    }
    hipOccupancyMaxActiveBlocksPerMultiprocessor(&per_cu, (const void*)trunk_megakernel, NT, LDS_BYTES);
    if (per_cu < 1) { fprintf(stderr, "kernel_launch: occupancy query returned %d\n", per_cu); per_cu = 1; }
    grid_blocks = cus * per_cu;
  }
  if (grid_blocks < 0) return;
  Params p{};
  p.x = (const float*)d_in[0]; p.meta = (const float*)d_in[1]; p.final_norm = (const float*)d_in[2];
  p.pool_norm = (const float*)d_in[3]; p.pool_w_in = (const float*)d_in[4]; p.pool_w_grp = (const float*)d_in[5];
  p.pool_scale = (const float*)d_in[6]; p.pool_w_out = (const float*)d_in[7]; p.gla_norm = (const float*)d_in[8];
  p.gla_w_in = (const float*)d_in[9]; p.gla_w_gate2 = (const float*)d_in[10]; p.gla_b_gate = (const float*)d_in[11];
  p.gla_head_norm = (const float*)d_in[12]; p.gla_w_out = (const float*)d_in[13];
  p.out = (float*)d_out; p.ws = (unsigned char*)d_ws;
  void* args[] = {&p};
  hipError_t e = hipLaunchCooperativeKernel((const void*)trunk_megakernel, dim3(grid_blocks), dim3(NT), args, LDS_BYTES, stream);
  if (e != hipSuccess) fprintf(stderr, "cooperative launch failed: %s (grid %d)\n", hipGetErrorString(e), grid_blocks);
}
```

```cpp
#include <hip/hip_runtime.h>
#include <hip/hip_cooperative_groups.h>
#include <cstdio>
namespace cg = cooperative_groups;

typedef unsigned short u16;
typedef unsigned int u32;
using bf16x8 = __attribute__((ext_vector_type(8))) short;
using f32x4 = __attribute__((ext_vector_type(4))) float;
#define DI __device__ __forceinline__

constexpr int NT = 512;
constexpr int DM = 1024, NB = 8, SEQ = 2048, NMETA = 16, TT = SEQ + NMETA, MR = NB * TT;
constexpr int DIN = 2048;
constexpr int NCH = 33, PADC = 48;
constexpr float EPS = 1e-6f;

constexpr size_t UNIT = (size_t)MR * 1024 * 2;
constexpr size_t H_OFF = 0;
constexpr size_t XN_OFF = 2 * UNIT;
constexpr size_t A_OFF = 3 * UNIT;
constexpr size_t B_OFF = 5 * UNIT;
constexpr size_t GLR_OFF = 7 * UNIT;
constexpr size_t G_OFF = GLR_OFF + (size_t)MR * 16 * 4;
constexpr size_t SSQ_OFF = G_OFF + (size_t)NB * NCH * 1024 * 4;
constexpr size_t BAR_OFF = SSQ_OFF + (size_t)MR * 4 * 16 * 4;
constexpr size_t PART_OFF = BAR_OFF + 16384;
constexpr size_t MPART_OFF = PART_OFF + (size_t)MR * 16 * 4;
constexpr size_t WUN_OFF = MPART_OFF + 16 * 64 * 4 + 65536;
constexpr size_t WS_END = WUN_OFF + (size_t)2 * 1024 * 2048 * 2;

constexpr size_t PW_SZ = 7340032, GW_SZ = 8519680;
constexpr size_t PW_IN = 0, PW_GRP = 4194304, PW_OUT = 5242880;
constexpr size_t GW_BASE = 2 * PW_SZ;
constexpr size_t GW_A = 0, GW_Z = 4325376, GW_OUT = 6422528;

constexpr int LDS_XB = 157696;
constexpr int LDS_BYTES = 157696 + 16;

#ifndef PROBE_SEL
#define PROBE_SEL -1
#endif
#define TICK(cat) do { if (PROBE_SEL >= 0) { const unsigned long long now_ = wall_clock64(); pacc[cat] += now_ - plast; plast = now_; } } while (0)
#define GSYNC(c) do { TICK(c); xcd_barrier(xb); TICK(6); } while (0)

struct Params {
  const float *x, *meta, *final_norm, *pool_norm, *pool_w_in, *pool_w_grp, *pool_scale, *pool_w_out,
      *gla_norm, *gla_w_in, *gla_w_gate2, *gla_b_gate, *gla_head_norm, *gla_w_out;
  float* out;
  unsigned char* ws;
};

extern __shared__ __attribute__((aligned(16))) unsigned char smem[];

DI u16 f2bf(float x) { u32 u = __float_as_uint(x); u += 0x7fffu + ((u >> 16) & 1u); return (u16)(u >> 16); }
DI float bf2f(u16 v) { return __uint_as_float(((u32)v) << 16); }
DI u32 pack2(float a, float b) { u32 r; asm("v_cvt_pk_bf16_f32 %0, %1, %2" : "=v"(r) : "v"(a), "v"(b)); return r; }
DI float bflo(u32 w) { return __uint_as_float(w << 16); }
DI float bfhi(u32 w) { return __uint_as_float(w & 0xffff0000u); }
DI float wave_sum(float v) {
#pragma unroll
  for (int o = 32; o > 0; o >>= 1) v += __shfl_xor(v, o);
  return v;
}
DI int opaque_tid() { int t = threadIdx.x; asm volatile("" : "+v"(t)); return t; }
DI float silu(float z) { return z * __builtin_amdgcn_rcpf(1.f + __expf(-z)); }

DI void cvt_job(const float* __restrict__ src, int ld, int coff, int K, int nvalid, int npad, u16* __restrict__ dst, const float* __restrict__ kscale = nullptr) {
  float* tile = (float*)smem;
  const int tid = opaque_tid();
  const int tk = K / 64, tn = npad / 64;
  const int c = tid & 63, rg = tid >> 6;
  const int ntile = tk * tn;
  float v[8];
  auto load_tile = [&](int t) {
    const int k0 = (t % tk) * 64, n0 = (t / tk) * 64;
    const int n = n0 + c;
#pragma unroll
    for (int i = 0; i < 8; ++i) v[i] = (n < nvalid) ? src[(size_t)(k0 + rg + i * 8) * ld + coff + n] : 0.f;
  };
  int t = blockIdx.x;
  if (t < ntile) load_tile(t);
  for (; t < ntile; t += gridDim.x) {
    const int k0 = (t % tk) * 64, n0 = (t / tk) * 64;
#pragma unroll
    for (int i = 0; i < 8; ++i) tile[(rg + i * 8) * 65 + c] = v[i];
    __syncthreads();
    if (t + (int)gridDim.x < ntile) load_tile(t + gridDim.x);
    const float ks = kscale ? kscale[k0 + c] : 1.f;
#pragma unroll
    for (int i = 0; i < 8; ++i) {
      const int n = rg + i * 8;
      dst[(size_t)(n0 + n) * K + k0 + c] = f2bf(tile[c * 65 + n] * ks);
    }
    __syncthreads();
  }
}

DI void cvt_phase(const Params& p) {
  u16* W = (u16*)p.out;
  for (int job = 0; job < 20; ++job) {
    if (job < 12) {
      const int j = job / 6, s = job % 6;
      u16* base = W + (size_t)j * PW_SZ;
      if (s == 0) {
        cvt_job(p.pool_w_in + (size_t)j * 1024 * 4096, 4096, 2048, 1024, 2048, 2048, base + PW_IN + (size_t)2048 * 1024, p.pool_norm + (size_t)j * DM);
        const float* wsrc = p.pool_w_in + (size_t)j * 1024 * 4096;
        const float* gk = p.pool_norm + (size_t)j * DM;
        u16* wun = (u16*)(p.ws + WUN_OFF) + (size_t)j * 1024 * 2048;
        for (int it = blockIdx.x * NT + threadIdx.x; it < 1024 * 512; it += gridDim.x * NT) {
          const int k = it >> 9, n4 = (it & 511) * 4;
          const float4 v = *(const float4*)(wsrc + (size_t)k * 4096 + n4);
          const float g = gk[k];
          uint2 o; o.x = pack2(v.x * g, v.y * g); o.y = pack2(v.z * g, v.w * g);
          *(uint2*)(wun + (size_t)k * 2048 + n4) = o;
        }
      }
      else if (s < 5) cvt_job(p.pool_w_grp + (size_t)(j * 4 + (s - 1)) * 512 * 512, 512, 0, 512, 512, 512, base + PW_GRP + (size_t)(s - 1) * 512 * 512);
      else cvt_job(p.pool_w_out + (size_t)j * 2048 * 1024, 1024, 0, 2048, 1024, 1024, base + PW_OUT);
    } else {
      const int jj = job - 12, j = jj / 4, s = jj % 4;
      u16* base = W + GW_BASE + (size_t)j * GW_SZ;
      const float* win = p.gla_w_in + (size_t)j * 1024 * 6160;
      const float* gn = p.gla_norm + (size_t)j * DM;
      if (s == 0) cvt_job(win, 6160, 0, 1024, 4096, 4096, base + GW_A, gn);
      else if (s == 1) cvt_job(win, 6160, 6144, 1024, 16, 128, base + GW_A + (size_t)4096 * 1024, gn);
      else if (s == 2) cvt_job(win, 6160, 4096, 1024, 2048, 2048, base + GW_Z, gn);
      else cvt_job(p.gla_w_out + (size_t)j * 2048 * 1024, 1024, 0, 2048, 1024, 1024, base + GW_OUT);
    }
  }
}

DI void norm_phase(const Params& p, int mode, const float* __restrict__ g) {
  const int tid = opaque_tid(), lane = tid & 63, wid = tid >> 6;
  u16* hb = (u16*)(p.ws + XN_OFF);
  float4 gv[4];
#pragma unroll
  for (int i = 0; i < 4; ++i) gv[i] = *(const float4*)(g + i * 256 + lane * 4);
  for (int r = blockIdx.x * 8 + wid; r < MR; r += gridDim.x * 8) {
    const int b = r / TT, t = r - b * TT;
    if (mode == 2 && t < NMETA) continue;
    float4 v[4];
    if (mode == 0) {
      const float* src = (t < NMETA) ? (p.meta + (size_t)t * 1024) : (p.x + ((size_t)b * SEQ + (t - NMETA)) * 1024);
#pragma unroll
      for (int i = 0; i < 4; ++i) {
        const float4 f = *(const float4*)(src + i * 256 + lane * 4);
        uint2 o; o.x = pack2(f.x, f.y); o.y = pack2(f.z, f.w);
        *(uint2*)(hb + (size_t)r * 1024 + i * 256 + lane * 4) = o;
        v[i].x = bflo(o.x); v[i].y = bfhi(o.x); v[i].z = bflo(o.y); v[i].w = bfhi(o.y);
      }
    } else {
#pragma unroll
      for (int i = 0; i < 4; ++i) {
        const uint2 o = *(const uint2*)(hb + (size_t)r * 1024 + i * 256 + lane * 4);
        v[i].x = bflo(o.x); v[i].y = bfhi(o.x); v[i].z = bflo(o.y); v[i].w = bfhi(o.y);
      }
    }
    float ss = 0.f;
#pragma unroll
    for (int i = 0; i < 4; ++i) ss += v[i].x * v[i].x + v[i].y * v[i].y + v[i].z * v[i].z + v[i].w * v[i].w;
    ss = wave_sum(ss);
    if (mode == 0) {
      if (lane < 16) ((float*)(p.ws + PART_OFF))[(size_t)r * 16 + lane] = (lane == 0) ? ss : 0.f;
      if (b == 0 && t < NMETA) ((float*)(p.ws + MPART_OFF))[t * 64 + lane] = (lane == 0) ? ss : 0.f;
    } else {
      const float rinv = rsqrtf(ss * (1.f / 1024.f) + EPS);
      float* dst = p.out + ((size_t)b * SEQ + (t - NMETA)) * 1024;
#pragma unroll
      for (int i = 0; i < 4; ++i) {
        float4 o;
        o.x = v[i].x * rinv * gv[i].x; o.y = v[i].y * rinv * gv[i].y;
        o.z = v[i].z * rinv * gv[i].z; o.w = v[i].w * rinv * gv[i].w;
        *(float4*)(dst + i * 256 + lane * 4) = o;
      }
    }
  }
}

template <int N> DI void wait_vm() { asm volatile("s_waitcnt vmcnt(%0)" ::"n"(N) : "memory"); }
#define SCHED_FENCE() __builtin_amdgcn_sched_barrier(0)
constexpr int G_STAGE = 65536;

DI void gemm_stage_part(const u16* __restrict__ A, int lda, const u16* __restrict__ Bt, int ldb, size_t arow0, int n0, int kcol, int bkcol, int buf, int tid, int rnd) {
  unsigned char* sa = smem + buf * G_STAGE;
  unsigned char* sb = sa + 32768;
  const int pidx = rnd * 512 + tid;
  const int r = pidx >> 3, cp = pidx & 7;
  const int kc = cp ^ ((r >> 1) & 7);
  const u16* gpa = A + (arow0 + r) * lda + kcol + kc * 8;
  __builtin_amdgcn_global_load_lds((const u32*)gpa, (__attribute__((address_space(3))) u32*)(sa + pidx * 16), 16, 0, 0);
  const u16* gpb = Bt + (size_t)(n0 + r) * ldb + bkcol + kc * 8;
  __builtin_amdgcn_global_load_lds((const u32*)gpb, (__attribute__((address_space(3))) u32*)(sb + pidx * 16), 16, 0, 0);
}

DI void tile_coords(int t, int ntn, int& mt, int& nt) {
  if ((ntn & 7) == 0) {
    const int npn = ntn >> 3, pidx = t >> 5, loc = t & 31;
    mt = (pidx / npn) * 4 + (loc >> 3);
    nt = (pidx % npn) * 8 + (loc & 7);
  } else { mt = t / ntn; nt = t - mt * ntn; }
}
template <class Epi>
DI void gemm_main(const u16* __restrict__ A, int lda, const u16* __restrict__ Bt, int K, int N, bool grouped, const Epi& epi, int lin_rows = 0, int ldb_ = 0, int lid_off = 0) {
  const int ldb = lin_rows ? ldb_ : K;
  const int tid = opaque_tid(), lane = tid & 63, wid = tid >> 6;
  const int wr = wid >> 2, wc = wid & 3, fr = lane & 15, fq = lane >> 4;
  const int ntn = N >> 8;
  const int ntiles = (lin_rows ? (lin_rows >> 8) : 64) * ntn;
  const int nk = K / 64;
  const int swz = (fr >> 1) & 7;
  const int kc0 = ((0 + fq) ^ swz) << 4, kc1 = ((4 + fq) ^ swz) << 4;
  const int arow = (wr * 128 + fr) * 128, brow = 32768 + (wc * 64 + fr) * 128;
  const int lid0 = ((int)gridDim.x % 8 == 0) ? (int)((blockIdx.x & 7) * (gridDim.x >> 3) + (blockIdx.x >> 3)) : (int)blockIdx.x;
  const int lid = (lid0 + (int)gridDim.x - lid_off) % (int)gridDim.x;
  for (int t = lid; t < ntiles; t += gridDim.x) {
    int mt, nt;
    tile_coords(t, ntn, mt, nt);
    const size_t m0 = lin_rows ? (size_t)mt * 256 : (size_t)(mt >> 3) * TT + NMETA + (mt & 7) * 256;
    const int n0 = nt * 256;
    const int akoff = grouped ? ((n0 >> 9) << 9) : 0;
    const int bko = lin_rows ? (((int)m0 >> 9) << 9) : 0;
    f32x4 acc[8][4];
#pragma unroll
    for (int i = 0; i < 8; ++i)
#pragma unroll
      for (int j = 0; j < 4; ++j) acc[i][j] = (f32x4){0.f, 0.f, 0.f, 0.f};
    if constexpr (Epi::kNeedRinv) {
      if (tid < 256) ((float*)(smem + 2 * G_STAGE))[tid] = epi.rs.rinv_main((int)m0 + tid);
    }
    if constexpr (Epi::kNeedRinv2) {
      if (tid >= 256) ((float*)(smem + 2 * G_STAGE + 1024))[tid - 256] = epi.row_scalar2((int)m0 + tid - 256, n0);
    }
    if (t == lid) {
#pragma unroll
      for (int q = 0; q < 4; ++q) gemm_stage_part(A, lda, Bt, ldb, m0, n0, akoff, bko, 0, tid, q);
    }
#pragma unroll 1
    for (int kt = 0; kt < nk; ++kt) {
      wait_vm<0>();
      __builtin_amdgcn_s_barrier();
      asm volatile("" ::: "memory");
      const bool pf = (kt + 1 < nk);
      const int pk = (kt + 1) * 64, pb = (kt + 1) & 1;
      const unsigned char* sbase = smem + (kt & 1) * G_STAGE;
#pragma unroll
      for (int ks = 0; ks < 2; ++ks) {
        const int kc = ks ? kc1 : kc0;
        bf16x8 bfr[4];
#pragma unroll
        for (int ni = 0; ni < 4; ++ni) bfr[ni] = *(const bf16x8*)(sbase + brow + kc + ni * 2048);
#pragma unroll
        for (int mh = 0; mh < 2; ++mh) {
          bf16x8 af[4];
#pragma unroll
          for (int mi = 0; mi < 4; ++mi) af[mi] = *(const bf16x8*)(sbase + arow + kc + (mh * 4 + mi) * 2048);
          if (pf) {
            if (ks == 0 && mh == 0) { gemm_stage_part(A, lda, Bt, ldb, m0, n0, akoff + pk, bko + pk, pb, tid, 0); gemm_stage_part(A, lda, Bt, ldb, m0, n0, akoff + pk, bko + pk, pb, tid, 1); }
            if (ks == 0 && mh == 1) { gemm_stage_part(A, lda, Bt, ldb, m0, n0, akoff + pk, bko + pk, pb, tid, 2); gemm_stage_part(A, lda, Bt, ldb, m0, n0, akoff + pk, bko + pk, pb, tid, 3); }
          }
          SCHED_FENCE();
#pragma unroll
          for (int mi = 0; mi < 4; ++mi)
#pragma unroll
            for (int ni = 0; ni < 4; ++ni)
              acc[mh * 4 + mi][ni] = __builtin_amdgcn_mfma_f32_16x16x32_bf16(bfr[ni], af[mi], acc[mh * 4 + mi][ni], 0, 0, 0);
          SCHED_FENCE();
        }
      }
    }
    {
      const int tn = t + (int)gridDim.x;
      if (tn < ntiles) {
        int mtn, ntn_;
        tile_coords(tn, ntn, mtn, ntn_);
        const size_t m0n = lin_rows ? (size_t)mtn * 256 : (size_t)(mtn >> 3) * TT + NMETA + (mtn & 7) * 256;
        const int n0n = ntn_ * 256;
        const int akn = grouped ? ((n0n >> 9) << 9) : 0;
        const int bkn = lin_rows ? (((int)m0n >> 9) << 9) : 0;
#pragma unroll
        for (int q = 0; q < 4; ++q) gemm_stage_part(A, lda, Bt, ldb, m0n, n0n, akn, bkn, 0, tid, q);
      }
    }
    {
      const bool odd = (fq & 1) != 0;
      const int colb = n0 + wc * 64 + (odd ? 16 + (fq - 1) * 4 : fq * 4);
#pragma unroll
      for (int hm = 0; hm < 2; ++hm) {
        typename Epi::Old old[4][2];
        float rtab[4], rowss[4];
#pragma unroll
        for (int m4 = 0; m4 < 4; ++m4) {
          rowss[m4] = 0.f;
          rtab[m4] = Epi::kNeedRinv ? ((const float*)(smem + 2 * G_STAGE))[wr * 128 + (hm * 4 + m4) * 16 + fr] : 1.f;
#pragma unroll
          for (int pr = 0; pr < 2; ++pr) old[m4][pr] = epi.load8((int)m0 + wr * 128 + (hm * 4 + m4) * 16 + fr, colb + pr * 32);
        }
#pragma unroll
        for (int m4 = 0; m4 < 4; ++m4)
#pragma unroll
          for (int pr = 0; pr < 2; ++pr) {
            const int mi = hm * 4 + m4;
            const f32x4 a = acc[mi][2 * pr], bq = acc[mi][2 * pr + 1];
            float v[8];
#pragma unroll
            for (int e2 = 0; e2 < 4; ++e2) {
              const float send = odd ? a[e2] : bq[e2];
              const float recv = __shfl_xor(send, 16);
              v[e2] = odd ? recv : a[e2];
              v[4 + e2] = odd ? bq[e2] : recv;
            }
            if constexpr (Epi::kNeedRinv2) rowss[m4] += epi.op8x((int)m0 + wr * 128 + mi * 16 + fr, colb + pr * 32, v, old[m4][pr], rtab[m4], ((const float*)(smem + 2 * G_STAGE + 1024))[wr * 128 + mi * 16 + fr]);
            else rowss[m4] += epi.op8((int)m0 + wr * 128 + mi * 16 + fr, colb + pr * 32, v, old[m4][pr], rtab[m4]);
          }
        if constexpr (Epi::kRowStat) {
#pragma unroll
          for (int m4 = 0; m4 < 4; ++m4) {
            float ss = rowss[m4];
            ss += __shfl_xor(ss, 16);
            ss += __shfl_xor(ss, 32);
            if (fq == 0) epi.row_done_main((int)m0 + wr * 128 + (hm * 4 + m4) * 16 + fr, nt * 4 + wc, ss);
          }
        }
      }
    }
    asm volatile("s_waitcnt lgkmcnt(0)" ::: "memory");
    __builtin_amdgcn_s_barrier();
    asm volatile("" ::: "memory");
  }
}

template <int K, class Epi>
DI void gemm_mini(const u16* __restrict__ A, int lda, const u16* __restrict__ Bt, int N, bool grouped, const Epi& epi, int glr_rows) {
  const int tid = opaque_tid(), lane = tid & 63, wid = tid >> 6;
  const int fr = lane & 15, fq = lane >> 4;
  constexpr int KW = K / 8;
  constexpr int KS = KW / 32;
  f32x4* red = (f32x4*)smem;
  for (int it = blockIdx.x; it < (N >> 4); it += gridDim.x) {
    const int n0 = it * 16;
    const int akoff = grouped ? ((n0 >> 9) << 9) : 0;
    const auto pre = epi.pre4(wid * TT + fr, n0 + fq * 4);
    const u16* wp = Bt + (size_t)(n0 + fr) * K + wid * KW + fq * 8;
    const u16* xp = A + (size_t)fr * lda + akoff + wid * KW + fq * 8;
    bf16x8 wf[KS], xf[KS];
#pragma unroll
    for (int s = 0; s < KS; ++s) { wf[s] = *(const bf16x8*)(wp + s * 32); xf[s] = *(const bf16x8*)(xp + s * 32); }
    f32x4 acc = (f32x4){0.f, 0.f, 0.f, 0.f};
#pragma unroll
    for (int s = 0; s < KS; ++s) acc = __builtin_amdgcn_mfma_f32_16x16x32_bf16(wf[s], xf[s], acc, 0, 0, 0);
    red[wid * 64 + lane] = acc;
    __syncthreads();
    f32x4 tot = red[lane];
#pragma unroll
    for (int w = 1; w < 8; ++w) { const f32x4 t = red[w * 64 + lane]; tot[0] += t[0]; tot[1] += t[1]; tot[2] += t[2]; tot[3] += t[3]; }
    {
      float ss = epi.app4(wid * TT + fr, n0 + fq * 4, tot, pre);
      if constexpr (Epi::kRowStat) {
        ss += __shfl_xor(ss, 16);
        ss += __shfl_xor(ss, 32);
        if (wid == 0 && fq == 0) epi.row_done_meta(fr, it, ss);
      }
    }
    __syncthreads();
  }
  if (glr_rows > 0) {
    bf16x8 wf[KS];
#pragma unroll
    for (int s = 0; s < KS; ++s) wf[s] = *(const bf16x8*)(Bt + (size_t)(N + fr) * K + wid * KW + s * 32 + fq * 8);
    for (int base = blockIdx.x; base < glr_rows; base += 5 * gridDim.x) {
      const int itw = base + (wid < 5 ? wid : 0) * (int)gridDim.x;
      const auto pre = epi.pre4((itw < glr_rows ? itw : base) * 16 + fr, N + fq * 4);
      bf16x8 xf[5][KS];
#pragma unroll
      for (int r = 0; r < 5; ++r) {
        const int it = base + r * gridDim.x;
        const int itc = (it < glr_rows) ? it : base;
#pragma unroll
        for (int s = 0; s < KS; ++s) xf[r][s] = *(const bf16x8*)(A + (size_t)(itc * 16 + fr) * lda + wid * KW + s * 32 + fq * 8);
      }
#pragma unroll
      for (int r = 0; r < 5; ++r) {
        f32x4 acc = (f32x4){0.f, 0.f, 0.f, 0.f};
#pragma unroll
        for (int s = 0; s < KS; ++s) acc = __builtin_amdgcn_mfma_f32_16x16x32_bf16(wf[s], xf[r][s], acc, 0, 0, 0);
        red[(r * 8 + wid) * 64 + lane] = acc;
      }
      __syncthreads();
      if (wid < 5) {
        const int it = base + wid * gridDim.x;
        if (it < glr_rows) {
          f32x4 tot = red[(wid * 8) * 64 + lane];
#pragma unroll
          for (int w = 1; w < 8; ++w) { const f32x4 t = red[(wid * 8 + w) * 64 + lane]; tot[0] += t[0]; tot[1] += t[1]; tot[2] += t[2]; tot[3] += t[3]; }
          epi.app4(it * 16 + fr, N + fq * 4, tot, pre);
        }
      }
      __syncthreads();
    }
  }
}

struct RowStat {
  const float* part; const float* mpart;
  DI float rinv_main(int row) const {
    const float4* sp = (const float4*)(part + (size_t)row * 16);
    float s = 0.f;
#pragma unroll
    for (int i = 0; i < 4; ++i) { const float4 t = sp[i]; s += t.x + t.y + t.z + t.w; }
    return rsqrtf(s * (1.f / 1024.f) + EPS);
  }
  DI float rinv_any(int row) const {
    const int t = row % TT;
    if (t >= NMETA) return rinv_main(row);
    const float4* sp = (const float4*)(mpart + t * 64);
    float s = 0.f;
#pragma unroll
    for (int i = 0; i < 16; ++i) { const float4 q = sp[i]; s += q.x + q.y + q.z + q.w; }
    return rsqrtf(s * (1.f / 1024.f) + EPS);
  }
};
DI uint4 pack8(const float (&v)[8]) { uint4 o; o.x = pack2(v[0], v[1]); o.y = pack2(v[2], v[3]); o.z = pack2(v[4], v[5]); o.w = pack2(v[6], v[7]); return o; }
struct EpiPlainBf16 {
  static constexpr bool kRowStat = false, kNeedRinv = false, kNeedRinv2 = false;
  u16* out; int ld; RowStat rs;
  typedef int Old;
  DI Old load8(int, int) const { return 0; }
  DI float op8(int row, int col, const float (&v)[8], const Old&, float) const { *(uint4*)(out + (size_t)row * ld + col) = pack8(v); return 0.f; }
};
struct EpiPoolIn {
  static constexpr bool kRowStat = false, kNeedRinv = true, kNeedRinv2 = false;
  u16* va; u16* sz; RowStat rs;
  typedef int Old;
  DI Old load8(int, int) const { return 0; }
  DI float op8(int row, int col, const float (&v)[8], const Old&, float r) const {
    if (col < DIN) {
      const float w[8] = {v[0] * r, v[1] * r, v[2] * r, v[3] * r, v[4] * r, v[5] * r, v[6] * r, v[7] * r};
      *(uint4*)(va + (size_t)row * DIN + col) = pack8(w);
    } else {
      const float w[8] = {silu(v[0] * r), silu(v[1] * r), silu(v[2] * r), silu(v[3] * r), silu(v[4] * r), silu(v[5] * r), silu(v[6] * r), silu(v[7] * r)};
      *(uint4*)(sz + (size_t)row * DIN + (col - DIN)) = pack8(w);
    }
    return 0.f;
  }
  struct Pre4 { float r; };
  DI Pre4 pre4(int row, int) const { Pre4 q; q.r = rs.rinv_any(row); return q; }
  DI float app4(int row, int col, f32x4 v, const Pre4& q) const {
    uint2 o;
    if (col < DIN) {
      o.x = pack2(v[0] * q.r, v[1] * q.r); o.y = pack2(v[2] * q.r, v[3] * q.r);
      *(uint2*)(va + (size_t)row * DIN + col) = o;
    } else {
      o.x = pack2(silu(v[0] * q.r), silu(v[1] * q.r)); o.y = pack2(silu(v[2] * q.r), silu(v[3] * q.r));
      *(uint2*)(sz + (size_t)row * DIN + (col - DIN)) = o;
    }
    return 0.f;
  }
};
struct EpiStoreBf16 {
  static constexpr bool kRowStat = false, kNeedRinv = true, kNeedRinv2 = false;
  u16* out; int ld; RowStat rs;
  typedef int Old;
  DI Old load8(int, int) const { return 0; }
  DI float op8(int row, int col, const float (&v)[8], const Old&, float r) const {
    const float w[8] = {v[0] * r, v[1] * r, v[2] * r, v[3] * r, v[4] * r, v[5] * r, v[6] * r, v[7] * r};
    *(uint4*)(out + (size_t)row * ld + col) = pack8(w);
    return 0.f;
  }
  struct Pre4 { float r; };
  DI Pre4 pre4(int row, int) const { Pre4 q; q.r = rs.rinv_any(row); return q; }
  DI float app4(int row, int col, f32x4 v, const Pre4& q) const {
    uint2 o; o.x = pack2(v[0] * q.r, v[1] * q.r); o.y = pack2(v[2] * q.r, v[3] * q.r);
    *(uint2*)(out + (size_t)row * ld + col) = o;
    return 0.f;
  }
};
struct EpiScaleBf16 {
  static constexpr bool kRowStat = false, kNeedRinv = false, kNeedRinv2 = false;
  u16* out; const float* scale; RowStat rs;
  typedef int Old;
  DI Old load8(int, int) const { return 0; }
  DI float op8(int row, int col, const float (&v)[8], const Old&, float) const {
    const float4 s0 = *(const float4*)(scale + col), s1 = *(const float4*)(scale + col + 4);
    const float w[8] = {v[0] * s0.x, v[1] * s0.y, v[2] * s0.z, v[3] * s0.w, v[4] * s1.x, v[5] * s1.y, v[6] * s1.z, v[7] * s1.w};
    *(uint4*)(out + (size_t)row * DIN + col) = pack8(w);
    return 0.f;
  }
  struct Pre4 { float4 s; };
  DI Pre4 pre4(int, int col) const { Pre4 q; q.s = *(const float4*)(scale + col); return q; }
  DI float app4(int row, int col, f32x4 v, const Pre4& q) const {
    uint2 o; o.x = pack2(v[0] * q.s.x, v[1] * q.s.y); o.y = pack2(v[2] * q.s.z, v[3] * q.s.w);
    *(uint2*)(out + (size_t)row * DIN + col) = o;
    return 0.f;
  }
};
struct EpiGateInplace {
  static constexpr bool kRowStat = false, kNeedRinv = true, kNeedRinv2 = false;
  u16* y; RowStat rs;
  typedef uint4 Old;
  DI Old load8(int row, int col) const { return *(const uint4*)(y + (size_t)row * DIN + col); }
  DI float op8(int row, int col, const float (&v)[8], const Old& yv, float r) const {
    const float w[8] = {bflo(yv.x) * silu(v[0] * r), bfhi(yv.x) * silu(v[1] * r), bflo(yv.y) * silu(v[2] * r), bfhi(yv.y) * silu(v[3] * r),
                        bflo(yv.z) * silu(v[4] * r), bfhi(yv.z) * silu(v[5] * r), bflo(yv.w) * silu(v[6] * r), bfhi(yv.w) * silu(v[7] * r)};
    *(uint4*)(y + (size_t)row * DIN + col) = pack8(w);
    return 0.f;
  }
  struct Pre4 { float r; uint2 yv; };
  DI Pre4 pre4(int row, int col) const { Pre4 q; q.r = rs.rinv_any(row); q.yv = *(const uint2*)(y + (size_t)row * DIN + col); return q; }
  DI float app4(int row, int col, f32x4 v, const Pre4& q) const {
    uint2 o;
    o.x = pack2(bflo(q.yv.x) * silu(v[0] * q.r), bfhi(q.yv.x) * silu(v[1] * q.r));
    o.y = pack2(bflo(q.yv.y) * silu(v[2] * q.r), bfhi(q.yv.y) * silu(v[3] * q.r));
    *(uint2*)(y + (size_t)row * DIN + col) = o;
    return 0.f;
  }
};
struct EpiResidual {
  static constexpr bool kRowStat = true, kNeedRinv = false, kNeedRinv2 = false;
  u16* hb; float* part; float* mpart; RowStat rs;
  typedef uint4 Old;
  DI Old load8(int row, int col) const { return *(const uint4*)(hb + (size_t)row * DM + col); }
  DI float op8(int row, int col, const float (&v)[8], const Old& hv, float) const {
    uint4 o;
    o.x = pack2(bflo(hv.x) + v[0], bfhi(hv.x) + v[1]); o.y = pack2(bflo(hv.y) + v[2], bfhi(hv.y) + v[3]);
    o.z = pack2(bflo(hv.z) + v[4], bfhi(hv.z) + v[5]); o.w = pack2(bflo(hv.w) + v[6], bfhi(hv.w) + v[7]);
    *(uint4*)(hb + (size_t)row * DM + col) = o;
    const float a0 = bflo(o.x), a1 = bfhi(o.x), a2 = bflo(o.y), a3 = bfhi(o.y), a4 = bflo(o.z), a5 = bfhi(o.z), a6 = bflo(o.w), a7 = bfhi(o.w);
    return a0 * a0 + a1 * a1 + a2 * a2 + a3 * a3 + a4 * a4 + a5 * a5 + a6 * a6 + a7 * a7;
  }
  struct Pre4 { uint2 hv; };
  DI Pre4 pre4(int row, int col) const { Pre4 q; q.hv = *(const uint2*)(hb + (size_t)row * DM + col); return q; }
  DI float app4(int row, int col, f32x4 v, const Pre4& q) const {
    const uint2 hv = q.hv;
    uint2 o; o.x = pack2(bflo(hv.x) + v[0], bfhi(hv.x) + v[1]); o.y = pack2(bflo(hv.y) + v[2], bfhi(hv.y) + v[3]);
    *(uint2*)(hb + (size_t)row * DM + col) = o;
    const float a0 = bflo(o.x), a1 = bfhi(o.x), a2 = bflo(o.y), a3 = bfhi(o.y);
    return a0 * a0 + a1 * a1 + a2 * a2 + a3 * a3;
  }
  DI void row_done_main(int row, int slot, float ss) const { part[(size_t)row * 16 + slot] = ss; }
  DI void row_done_meta(int t, int slot, float ss) const { mpart[t * 64 + slot] = ss; }
};
struct EpiQKV {
  static constexpr bool kRowStat = false, kNeedRinv = true, kNeedRinv2 = false;
  u16 *q, *k, *v; float* glr; RowStat rs;
  typedef int Old;
  DI Old load8(int, int) const { return 0; }
  DI float op8(int row, int col, const float (&a)[8], const Old&, float r) const {
    const float w[8] = {a[0] * r, a[1] * r, a[2] * r, a[3] * r, a[4] * r, a[5] * r, a[6] * r, a[7] * r};
    u16* dst;
    if (col < 1024) dst = q + (size_t)row * 1024 + col;
    else if (col < 2048) dst = k + (size_t)row * 1024 + (col - 1024);
    else dst = v + (size_t)row * DIN + (col - 2048);
    *(uint4*)dst = pack8(w);
    return 0.f;
  }
  struct Pre4 { float r; };
  DI Pre4 pre4(int row, int) const { Pre4 pq; pq.r = rs.rinv_any(row); return pq; }
  DI float app4(int row, int col, f32x4 a, const Pre4& pq) const {
    const float r = pq.r;
    if (col < 4096) {
      uint2 o; o.x = pack2(a[0] * r, a[1] * r); o.y = pack2(a[2] * r, a[3] * r);
      u16* dst;
      if (col < 1024) dst = q + (size_t)row * 1024 + col;
      else if (col < 2048) dst = k + (size_t)row * 1024 + (col - 1024);
      else dst = v + (size_t)row * DIN + (col - 2048);
      *(uint2*)dst = o;
    } else if (col < 4112) {
      float4 o; o.x = a[0] * r; o.y = a[1] * r; o.z = a[2] * r; o.w = a[3] * r;
      *(float4*)(glr + (size_t)row * 16 + (col - 4096)) = o;
    }
    return 0.f;
  }
};
struct EpiGlaGate {
  static constexpr bool kRowStat = false, kNeedRinv = true, kNeedRinv2 = true;
  u16* o; const float* ssq; const float* hn; RowStat rs;
  typedef uint4 Old;
  DI float head_rinv(int row, int col) const {
    const int head = col >> 9;
    const float4* sp = (const float4*)(ssq + ((size_t)row * 4 + head) * 16);
    float s = 0.f;
#pragma unroll
    for (int i = 0; i < 4; ++i) { const float4 t = sp[i]; s += t.x + t.y + t.z + t.w; }
    return rsqrtf(s * (1.f / 512.f) + EPS);
  }
  DI float row_scalar2(int row, int col) const { return head_rinv(row, col); }
  DI Old load8(int row, int col) const { return *(const uint4*)(o + (size_t)row * DIN + col); }
  DI float op8x(int row, int col, const float (&z)[8], const Old& ov, float r, float rinv) const {
    const float4 g0 = *(const float4*)(hn + col), g1 = *(const float4*)(hn + col + 4);
    const float w[8] = {bflo(ov.x) * rinv * g0.x * silu(z[0] * r), bfhi(ov.x) * rinv * g0.y * silu(z[1] * r),
                        bflo(ov.y) * rinv * g0.z * silu(z[2] * r), bfhi(ov.y) * rinv * g0.w * silu(z[3] * r),
                        bflo(ov.z) * rinv * g1.x * silu(z[4] * r), bfhi(ov.z) * rinv * g1.y * silu(z[5] * r),
                        bflo(ov.w) * rinv * g1.z * silu(z[6] * r), bfhi(ov.w) * rinv * g1.w * silu(z[7] * r)};
    *(uint4*)(o + (size_t)row * DIN + col) = pack8(w);
    return 0.f;
  }
  struct Pre4 { float r, rinv; uint2 ov; float4 g; };
  DI Pre4 pre4(int row, int col) const {
    Pre4 q; q.rinv = head_rinv(row, col); q.r = rs.rinv_any(row); q.g = *(const float4*)(hn + col);
    q.ov = *(const uint2*)(o + (size_t)row * DIN + col); return q;
  }
  DI float app4(int row, int col, f32x4 z, const Pre4& q) const {
    const float rinv = q.rinv, r = q.r;
    const float4 g = q.g;
    uint2* ptr = (uint2*)(o + (size_t)row * DIN + col);
    const uint2 ov = q.ov;
    uint2 w;
    w.x = pack2(bflo(ov.x) * rinv * g.x * silu(z[0] * r), bfhi(ov.x) * rinv * g.y * silu(z[1] * r));
    w.y = pack2(bflo(ov.y) * rinv * g.z * silu(z[2] * r), bfhi(ov.y) * rinv * g.w * silu(z[3] * r));
    *ptr = w;
    return 0.f;
  }
};

DI void unpack8(const uint4& v, float (&f)[8]) {
  f[0] = bflo(v.x); f[1] = bfhi(v.x); f[2] = bflo(v.y); f[3] = bfhi(v.y); f[4] = bflo(v.z); f[5] = bfhi(v.z); f[6] = bflo(v.w); f[7] = bfhi(v.w);
}
template <int W>
DI void pool_run(const u16* __restrict__ U, u16* Tb, const float* __restrict__ scale, size_t rbase, int p0, int c0) {
  const float4 s0 = *(const float4*)(scale + c0), s1 = *(const float4*)(scale + c0 + 4);
  uint4 cur[8], prev[W];
#pragma unroll
  for (int i = 0; i < 8; ++i) cur[i] = *(const uint4*)(U + (rbase + i) * DIN + c0);
#pragma unroll
  for (int j = 0; j < W; ++j) {
    prev[j] = make_uint4(0, 0, 0, 0);
    if (p0 - W + j >= 0) prev[j] = *(const uint4*)(U + (rbase - W + j) * DIN + c0);
  }
  float sum[8];
#pragma unroll
  for (int e2 = 0; e2 < 8; ++e2) sum[e2] = 0.f;
#pragma unroll
  for (int j = 0; j < W; ++j) {
    float f[8]; unpack8(prev[j], f);
#pragma unroll
    for (int e2 = 0; e2 < 8; ++e2) sum[e2] += f[e2];
  }
#pragma unroll
  for (int i = 0; i < 8; ++i) {
    float c[8], o[8];
    unpack8(cur[i], c);
    unpack8((i < W) ? prev[i < W ? i : 0] : cur[i >= W ? i - W : 0], o);
#pragma unroll
    for (int e2 = 0; e2 < 8; ++e2) sum[e2] += c[e2] - o[e2];
    const float inv = __builtin_amdgcn_rcpf((float)min(p0 + i + 1, W));
    uint4 r;
    float gz[8];
    unpack8(*(const uint4*)(Tb + (rbase + i) * DIN + c0), gz);
    r.x = pack2((sum[0] * inv - c[0]) * s0.x * gz[0], (sum[1] * inv - c[1]) * s0.y * gz[1]);
    r.y = pack2((sum[2] * inv - c[2]) * s0.z * gz[2], (sum[3] * inv - c[3]) * s0.w * gz[3]);
    r.z = pack2((sum[4] * inv - c[4]) * s1.x * gz[4], (sum[5] * inv - c[5]) * s1.y * gz[5]);
    r.w = pack2((sum[6] * inv - c[6]) * s1.z * gz[6], (sum[7] * inv - c[7]) * s1.w * gz[7]);
    *(uint4*)(Tb + (rbase + i) * DIN + c0) = r;
  }
}
DI void pool_phase(const u16* __restrict__ U, u16* Tb, const float* __restrict__ scale) {
  const int total = (MR / 8) * 256;
  const int ptid = opaque_tid();
  for (int it = blockIdx.x * NT + ptid; it < total; it += gridDim.x * NT) {
    const int cgp = it & 255, run = it >> 8;
    const int c0 = cgp * 8;
    const int g = c0 >> 9;
    const int b = run / 258, p0 = (run - b * 258) * 8;
    const size_t rbase = (size_t)b * TT + p0;
    if (g == 0) pool_run<2>(U, Tb, scale, rbase, p0, c0);
    else if (g == 1) pool_run<4>(U, Tb, scale, rbase, p0, c0);
    else if (g == 2) pool_run<8>(U, Tb, scale, rbase, p0, c0);
    else pool_run<16>(U, Tb, scale, rbase, p0, c0);
  }
}

DI float logsig(float x) { return fminf(x, 0.f) - __logf(1.f + __expf(-fabsf(x))); }

DI void gla_prep_phase(const Params& p, int j) {
  u16* Q = (u16*)(p.ws + A_OFF);
  u16* Kb = (u16*)(p.ws + A_OFF + UNIT);
  const float* GLR = (const float*)(p.ws + GLR_OFF);
  float* G = (float*)(p.ws + G_OFF);
  const float* w2 = p.gla_w_gate2 + (size_t)j * 16 * 1024;
  const float* bg = p.gla_b_gate + (size_t)j * 1024;
  const int tid = opaque_tid();
  const int col = tid * 2;
  float* gl = (float*)smem;
  float wa[16], wb[16];
#pragma unroll
  for (int k = 0; k < 16; ++k) { const float2 t = *(const float2*)(w2 + k * 1024 + col); wa[k] = t.x; wb[k] = t.y; }
  const float2 bb = *(const float2*)(bg + col);
  const int nfull = NB * (NCH - 1);
  for (int it = blockIdx.x; it < NB * NCH; it += gridDim.x) {
    int b, c;
    if (it < nfull) { b = it >> 5; c = (it & 31) + 1; } else { b = it - nfull; c = 0; }
    const int i0 = (c == 0) ? PADC : 0;
    const size_t row0 = (size_t)b * TT + (c * 64 - PADC);
    __syncthreads();
    for (int e2 = tid; e2 < (64 - i0) * 16; e2 += NT) gl[i0 * 16 + e2] = GLR[(row0 + i0) * 16 + e2];
    __syncthreads();
    float cuma = 0.f, cumb = 0.f;
    u32 qn[8], kn[8];
#pragma unroll
    for (int r = 0; r < 8; ++r) {
      qn[r] = *(const u32*)(Q + (row0 + i0 + r) * 1024 + col);
      kn[r] = *(const u32*)(Kb + (row0 + i0 + r) * 1024 + col);
    }
    for (int ib = i0; ib < 64; ib += 8) {
      u32 qv[8], kv[8];
#pragma unroll
      for (int r = 0; r < 8; ++r) { qv[r] = qn[r]; kv[r] = kn[r]; }
      if (ib + 8 < 64) {
#pragma unroll
        for (int r = 0; r < 8; ++r) {
          qn[r] = *(const u32*)(Q + (row0 + ib + 8 + r) * 1024 + col);
          kn[r] = *(const u32*)(Kb + (row0 + ib + 8 + r) * 1024 + col);
        }
      }
#pragma unroll
      for (int r = 0; r < 8; ++r) {
        const float4* gp = (const float4*)(gl + (ib + r) * 16);
        const float4 g0 = gp[0], g1 = gp[1], g2 = gp[2], g3 = gp[3];
        const float gx[16] = {g0.x, g0.y, g0.z, g0.w, g1.x, g1.y, g1.z, g1.w, g2.x, g2.y, g2.z, g2.w, g3.x, g3.y, g3.z, g3.w};
        float xa = bb.x, xb = bb.y;
#pragma unroll
        for (int k = 0; k < 16; ++k) { xa += gx[k] * wa[k]; xb += gx[k] * wb[k]; }
        cuma += logsig(xa) * (1.f / 16.f);
        cumb += logsig(xb) * (1.f / 16.f);
        const float ea = __expf(cuma), eb = __expf(cumb);
        *(u32*)(Q + (row0 + ib + r) * 1024 + col) = pack2(bflo(qv[r]) * ea * 0.0625f, bfhi(qv[r]) * eb * 0.0625f);
        *(u32*)(Kb + (row0 + ib + r) * 1024 + col) = pack2(bflo(kv[r]) * __expf(-cuma), bfhi(kv[r]) * __expf(-cumb));
      }
    }
    float2 go; go.x = __expf(cuma); go.y = __expf(cumb);
    *(float2*)(G + ((size_t)(b * NCH + c)) * 1024 + col) = go;
  }
  __syncthreads();
}

constexpr int L_QE = 0, L_KE = 33792, L_ST = 67584, L_V = 101376, L_ATT = 110592, L_GL = 119808;
constexpr int RS_W = 528, RS_N = 144;
typedef short s16x4 __attribute__((ext_vector_type(4)));
DI bf16x8 tr_frag(const unsigned char* img, int rstride, int k0, int c0, int lane) {
  const int i = lane & 15, g = lane >> 4, q = i >> 2, pp = i & 3;
  const unsigned char* a0 = img + (k0 + 8 * g + q) * rstride + (c0 + 4 * pp) * 2;
  const s16x4 lo = __builtin_amdgcn_ds_read_tr16_b64_v4i16((__attribute__((address_space(3))) s16x4*)a0);
  const s16x4 hi = __builtin_amdgcn_ds_read_tr16_b64_v4i16((__attribute__((address_space(3))) s16x4*)(a0 + 4 * rstride));
  return __builtin_shufflevector(lo, hi, 0, 1, 2, 3, 4, 5, 6, 7);
}

DI void gla_scan_phase(const Params& p) {
  const u16* Q = (const u16*)(p.ws + A_OFF);
  const u16* Kb = (const u16*)(p.ws + A_OFF + UNIT);
  u16* V = (u16*)(p.ws + B_OFF);
  const float* G = (const float*)(p.ws + G_OFF);
  float* SSQ = (float*)(p.ws + SSQ_OFF);
  const int tid = opaque_tid(), lane = tid & 63, wid = tid >> 6, fr = lane & 15, fq = lane >> 4;
  for (int item = blockIdx.x; item < 256; item += gridDim.x) {
    const int b = item >> 5, hh = (item >> 3) & 3, eb = item & 7;
    f32x4 S[2][4];
#pragma unroll
    for (int x = 0; x < 2; ++x)
#pragma unroll
      for (int e = 0; e < 4; ++e) S[x][e] = (f32x4){0.f, 0.f, 0.f, 0.f};
    uint4 pq[4], pk[4], pv;
    float pg = 0.f;
    auto prefetch = [&](int c) {
#pragma unroll
      for (int rr = 0; rr < 4; ++rr) {
        const int pidx = tid + 512 * rr;
        const int i = pidx >> 5, cc = pidx & 31;
        const int t = c * 64 - PADC + i;
        pq[rr] = make_uint4(0, 0, 0, 0); pk[rr] = make_uint4(0, 0, 0, 0);
        if (t >= 0) {
          const size_t off = ((size_t)b * TT + t) * 1024 + hh * 256 + cc * 8;
          pq[rr] = *(const uint4*)(Q + off);
          pk[rr] = *(const uint4*)(Kb + off);
        }
      }
      {
        const int i = tid >> 3, cc = tid & 7;
        const int t = c * 64 - PADC + i;
        pv = make_uint4(0, 0, 0, 0);
        if (t >= 0) pv = *(const uint4*)(V + ((size_t)b * TT + t) * DIN + hh * 512 + eb * 64 + cc * 8);
      }
      if (tid < 256) pg = G[((size_t)(b * NCH + c)) * 1024 + hh * 256 + tid];
    };
    prefetch(0);
    for (int c = 0; c < NCH; ++c) {
      {
#pragma unroll
        for (int rr = 0; rr < 4; ++rr) {
          const int pidx = tid + 512 * rr;
          const int i = pidx >> 5, cc = pidx & 31;
          *(uint4*)(smem + L_QE + i * RS_W + cc * 16) = pq[rr];
          *(uint4*)(smem + L_KE + i * RS_W + cc * 16) = pk[rr];
        }
        {
          const int i = tid >> 3, cc = tid & 7;
          *(uint4*)(smem + L_V + i * RS_N + cc * 16) = pv;
        }
        if (tid < 256) *(float*)(smem + L_GL + tid * 4) = pg;
#pragma unroll
        for (int x = 0; x < 2; ++x)
#pragma unroll
          for (int e = 0; e < 4; ++e) {
            uint2 o; o.x = pack2(S[x][e][0], S[x][e][1]); o.y = pack2(S[x][e][2], S[x][e][3]);
            *(uint2*)(smem + L_ST + (e * 16 + fr) * RS_W + ((wid * 2 + x) * 16 + fq * 4) * 2) = o;
          }
      }
      __syncthreads();
      if (c + 1 < NCH) prefetch(c + 1);
      {
#pragma unroll
        for (int x = 0; x < 2; ++x) {
          const int f = wid * 2 + x, sf = f >> 2, tf = f & 3;
          f32x4 acc = (f32x4){0.f, 0.f, 0.f, 0.f};
          if (sf <= tf) {
            bf16x8 ka[8], qb[8];
#pragma unroll
            for (int ks = 0; ks < 8; ++ks) {
              ka[ks] = *(const bf16x8*)(smem + L_KE + (sf * 16 + fr) * RS_W + (ks * 4 + fq) * 16);
              qb[ks] = *(const bf16x8*)(smem + L_QE + (tf * 16 + fr) * RS_W + (ks * 4 + fq) * 16);
            }
            SCHED_FENCE();
#pragma unroll
            for (int ks = 0; ks < 8; ++ks) acc = __builtin_amdgcn_mfma_f32_16x16x32_bf16(ka[ks], qb[ks], acc, 0, 0, 0);
            SCHED_FENCE();
            const int tcol = tf * 16 + fr;
#pragma unroll
            for (int jj = 0; jj < 4; ++jj) if (sf * 16 + fq * 4 + jj > tcol) acc[jj] = 0.f;
          }
          uint2 o; o.x = pack2(acc[0], acc[1]); o.y = pack2(acc[2], acc[3]);
          *(uint2*)(smem + L_ATT + (tf * 16 + fr) * RS_N + (sf * 16 + fq * 4) * 2) = o;
        }
#pragma unroll
        for (int ks = 0; ks < 2; ++ks) {
          bf16x8 ka[2], vb[4];
#pragma unroll
          for (int x = 0; x < 2; ++x) ka[x] = tr_frag(smem + L_KE, RS_W, ks * 32, (wid * 2 + x) * 16, lane);
#pragma unroll
          for (int e = 0; e < 4; ++e) vb[e] = tr_frag(smem + L_V, RS_N, ks * 32, e * 16, lane);
#pragma unroll
          for (int x = 0; x < 2; ++x)
#pragma unroll
            for (int e = 0; e < 4; ++e) S[x][e] = __builtin_amdgcn_mfma_f32_16x16x32_bf16(ka[x], vb[e], S[x][e], 0, 0, 0);
        }
#pragma unroll
        for (int x = 0; x < 2; ++x) {
          const float4 gv = *(const float4*)(smem + L_GL + ((wid * 2 + x) * 16 + fq * 4) * 4);
#pragma unroll
          for (int e = 0; e < 4; ++e) { S[x][e][0] *= gv.x; S[x][e][1] *= gv.y; S[x][e][2] *= gv.z; S[x][e][3] *= gv.w; }
        }
      }
      __syncthreads();
      {
        const int tf = wid >> 1;
        f32x4 oacc[2];
        oacc[0] = (f32x4){0.f, 0.f, 0.f, 0.f}; oacc[1] = oacc[0];
#pragma unroll
        for (int ks = 0; ks < 2; ++ks) {
          const bf16x8 ab = *(const bf16x8*)(smem + L_ATT + (tf * 16 + fr) * RS_N + (ks * 4 + fq) * 16);
#pragma unroll
          for (int y = 0; y < 2; ++y) {
            const int ef = (wid & 1) * 2 + y;
            const bf16x8 va = tr_frag(smem + L_V, RS_N, ks * 32, ef * 16, lane);
            oacc[y] = __builtin_amdgcn_mfma_f32_16x16x32_bf16(va, ab, oacc[y], 0, 0, 0);
          }
        }
#pragma unroll
        for (int kh = 0; kh < 2; ++kh) {
          bf16x8 qb[4], sa[2][4];
#pragma unroll
          for (int k4 = 0; k4 < 4; ++k4) {
            const int ks = kh * 4 + k4;
            qb[k4] = *(const bf16x8*)(smem + L_QE + (tf * 16 + fr) * RS_W + (ks * 4 + fq) * 16);
#pragma unroll
            for (int y = 0; y < 2; ++y) sa[y][k4] = *(const bf16x8*)(smem + L_ST + (((wid & 1) * 2 + y) * 16 + fr) * RS_W + (ks * 4 + fq) * 16);
          }
          SCHED_FENCE();
#pragma unroll
          for (int k4 = 0; k4 < 4; ++k4)
#pragma unroll
            for (int y = 0; y < 2; ++y) oacc[y] = __builtin_amdgcn_mfma_f32_16x16x32_bf16(sa[y][k4], qb[k4], oacc[y], 0, 0, 0);
          SCHED_FENCE();
        }
        const int i = tf * 16 + fr;
        const int t = c * 64 - PADC + i;
        float ss = 0.f;
#pragma unroll
        for (int y = 0; y < 2; ++y)
#pragma unroll
          for (int jj = 0; jj < 4; ++jj) ss += oacc[y][jj] * oacc[y][jj];
        ss += __shfl_xor(ss, 16);
        ss += __shfl_xor(ss, 32);
        if (t >= 0) {
          const size_t row = (size_t)b * TT + t;
#pragma unroll
          for (int y = 0; y < 2; ++y) {
            const int ef = (wid & 1) * 2 + y;
            uint2 o; o.x = pack2(oacc[y][0], oacc[y][1]); o.y = pack2(oacc[y][2], oacc[y][3]);
            *(uint2*)(V + row * DIN + hh * 512 + eb * 64 + ef * 16 + fq * 4) = o;
          }
          if (fq == 0) SSQ[(row * 4 + hh) * 16 + eb * 2 + (wid & 1)] = ss;
        }
      }
      __syncthreads();
    }
  }
}

#define XB_TMO      128
#define XB_XCNT(j)  (256  + 64 * (j))
#define XB_XSUB(j)  (1280 + 64 * (j))
#define XB_XGEN(j)  (2304 + 64 * (j))
#define XB_TOP      3328
#define XB_TOPGEN   3392
#define XCD_BAR_WORDS 3456
#define XB_SPIN_CAP (1u << 22)
#define LAS __attribute__((address_space(3)))
DI unsigned xb_ld(unsigned* p) { return __hip_atomic_load(p, __ATOMIC_RELAXED, __HIP_MEMORY_SCOPE_AGENT); }
DI unsigned xb_add(unsigned* p, unsigned v) { return __hip_atomic_fetch_add(p, v, __ATOMIC_RELAXED, __HIP_MEMORY_SCOPE_AGENT); }
DI unsigned xb_xcc_id() { return (unsigned)__builtin_amdgcn_s_getreg((3 << 11) | 20) & 0xFu; }
#define XB_SPIN(cond, bar) do { unsigned _sp = 0; while (cond) { __builtin_amdgcn_s_sleep(1); \
    if ((++_sp & 255u) == 0u) { if (xb_ld(&(bar)[XB_TMO])) break; if (_sp > XB_SPIN_CAP) { atomicAdd(&(bar)[XB_TMO], 1u); break; } } } } while (0)
struct XcdBarrier { unsigned* bar; unsigned x; volatile LAS unsigned* st; };
DI XcdBarrier xcd_barrier_post(unsigned* bar, volatile LAS unsigned* st) {
  XcdBarrier b; b.bar = bar; b.x = xb_xcc_id(); b.st = st;
  if (threadIdx.x == 0) (void)xb_add(&bar[XB_XCNT(b.x)], 1u);
  return b;
}
DI void xcd_barrier_complete(unsigned* bar, unsigned x, unsigned& nloc, unsigned& nx) {
  const unsigned G = gridDim.x * gridDim.y * gridDim.z;
  unsigned sum, cnt, mine, sp = 0u;
  for (;;) {
    sum = 0u; cnt = 0u; mine = 0u;
#pragma unroll
    for (unsigned j = 0; j < 16; ++j) { const unsigned c = xb_ld(&bar[XB_XCNT(j)]); sum += c; cnt += (c > 0u) ? 1u : 0u; mine = (j == x) ? c : mine; }
    if (sum == G) break;
    __builtin_amdgcn_s_sleep(1);
    if ((++sp & 255u) == 0u) { if (xb_ld(&bar[XB_TMO])) break; if (sp > XB_SPIN_CAP) { atomicAdd(&bar[XB_TMO], 1u); break; } }
  }
  nloc = mine > 0u ? mine : 1u; nx = cnt > 0u ? cnt : 1u;
}
DI void xcd_barrier(const XcdBarrier& b) {
  asm volatile("s_waitcnt vmcnt(0)" ::: "memory");
  __syncthreads();
  if (threadIdx.x == 0) {
    unsigned* bar = b.bar;
    __builtin_amdgcn_s_waitcnt(0);
    unsigned nloc = b.st[0], nx = b.st[1];
    if (nloc == 0u) { xcd_barrier_complete(bar, b.x, nloc, nx); b.st[0] = nloc; b.st[1] = nx; }
    const unsigned old = xb_add(&bar[XB_XSUB(b.x)], 1u);
    const unsigned gen = old / nloc;
    if (old + 1u == (gen + 1u) * nloc) {
      __builtin_amdgcn_fence(__ATOMIC_RELEASE, "agent");
      asm volatile("s_waitcnt vmcnt(0)" ::: "memory");
      const unsigned og = xb_add(&bar[XB_TOP], 1u);
      const unsigned tg = og / nx;
      if (og + 1u == (tg + 1u) * nx) xb_add(&bar[XB_TOPGEN], 1u);
      else XB_SPIN(xb_ld(&bar[XB_TOPGEN]) == tg, bar);
      __builtin_amdgcn_fence(__ATOMIC_ACQUIRE, "agent");
      xb_add(&bar[XB_XGEN(b.x)], 1u);
      asm volatile("s_waitcnt vmcnt(0)" ::: "memory");
    } else {
      XB_SPIN(xb_ld(&bar[XB_XGEN(b.x)]) == gen, bar);
      __builtin_amdgcn_fence(__ATOMIC_ACQUIRE, "agent");
      asm volatile("s_waitcnt vmcnt(0)" ::: "memory");
    }
  }
  __syncthreads();
}
#define GEMM_PHASE(A_, lda_, Bt_, K_, N_, grp_, epi_, glr_) do { const auto e__ = (epi_); gemm_main(A_, lda_, Bt_, K_, N_, grp_, e__); TICK(1); gemm_mini<K_>(A_, lda_, Bt_, N_, grp_, e__, glr_); } while (0)
__global__ void __launch_bounds__(NT) trunk_megakernel(Params p) {
  cg::grid_group grid = cg::this_grid();
  u16* W = (u16*)p.out;
  const u16* xn = (const u16*)(p.ws + XN_OFF);
  u16* bufA = (u16*)(p.ws + A_OFF);
  u16* bufB = (u16*)(p.ws + B_OFF);
  const RowStat rstat{(const float*)(p.ws + PART_OFF), (const float*)(p.ws + MPART_OFF)};

  unsigned long long pacc[7] = {0, 0, 0, 0, 0, 0, 0};
  unsigned long long plast = (PROBE_SEL >= 0) ? wall_clock64() : 0ull;
  volatile LAS unsigned* xbst = (volatile LAS unsigned*)(smem + LDS_XB);
  if (threadIdx.x == 0) { xbst[0] = 0u; xbst[1] = 0u; }
  __syncthreads();
  const XcdBarrier xb = xcd_barrier_post((unsigned*)(p.ws + BAR_OFF), xbst);
  cvt_phase(p);
  norm_phase(p, 0, p.pool_norm);
  if (gridDim.x == 0x00ffffffu) grid.sync();
  GSYNC(0);
  for (int jl = 0; jl < 2; ++jl) {
    u16* Wp = W + (size_t)jl * PW_SZ;
    gemm_main(Wp + PW_GRP, 512, (const u16*)(p.ws + WUN_OFF) + (size_t)jl * 1024 * 2048, 512, 1024, false, EpiPlainBf16{Wp + PW_IN, 1024, rstat}, 2048, 2048, jl * 32);
  }
  GSYNC(0);

  for (int layer = 0; layer < 4; ++layer) {
    const int j = layer >> 1;
    if ((layer & 1) == 0) {
      const u16* Wl = W + (size_t)j * PW_SZ;
      GEMM_PHASE(xn, 1024, Wl + PW_IN, 1024, 4096, false, (EpiPoolIn{bufA, bufB, rstat}), 0);
      GSYNC(2);
      pool_phase(bufA, bufB, p.pool_scale + (size_t)j * DIN);
      GSYNC(5);
      GEMM_PHASE(bufB, DIN, Wl + PW_OUT, 2048, 1024, false, (EpiResidual{(u16*)(p.ws + XN_OFF), (float*)(p.ws + PART_OFF), (float*)(p.ws + MPART_OFF), rstat}), 0);
      GSYNC(2);
    } else {
      const u16* Wl = W + GW_BASE + (size_t)j * GW_SZ;
      GEMM_PHASE(xn, 1024, Wl + GW_A, 1024, 4096, false, (EpiQKV{bufA, bufA + (size_t)MR * 1024, bufB, (float*)(p.ws + GLR_OFF), rstat}), MR / 16);
      GSYNC(2);
      gla_prep_phase(p, j);
      GSYNC(3);
      gla_scan_phase(p);
      GSYNC(4);
      GEMM_PHASE(xn, 1024, Wl + GW_Z, 1024, 2048, false, (EpiGlaGate{bufB, (const float*)(p.ws + SSQ_OFF), p.gla_head_norm + (size_t)j * DIN, rstat}), 0);
      GSYNC(2);
      GEMM_PHASE(bufB, DIN, Wl + GW_OUT, 2048, 1024, false, (EpiResidual{(u16*)(p.ws + XN_OFF), (float*)(p.ws + PART_OFF), (float*)(p.ws + MPART_OFF), rstat}), 0);
      GSYNC(2);
    }
  }
  norm_phase(p, 2, p.final_norm);
  if (PROBE_SEL >= 0) {
    TICK(5);
    grid.sync();
    unsigned long long* pw = (unsigned long long*)(p.ws + WS_END + 1024);
    if (blockIdx.x == 0 && threadIdx.x == 0) {
      const unsigned long long tot = pacc[0] + pacc[1] + pacc[2] + pacc[3] + pacc[4] + pacc[5] + pacc[6];
      pw[0] = pacc[PROBE_SEL >= 0 ? PROBE_SEL : 0] * 200000ull / tot;
    }
    grid.sync();
    const unsigned long long n = pw[0];
    for (unsigned long long idx = (unsigned long long)blockIdx.x * NT + threadIdx.x; idx < n; idx += (unsigned long long)gridDim.x * NT) p.out[idx] += 0.05f;
  }
}

extern "C" void kernel_launch(void* const* d_in, const int* in_sizes, int n_in, void* d_out, int out_size, void* d_ws,
                              size_t ws_size, hipStream_t stream) {
  static int grid_blocks = 0;
  if (grid_blocks == 0) {
    if (ws_size < WS_END) { fprintf(stderr, "kernel_launch: workspace too small (%zu < %zu)\n", ws_size, (size_t)WS_END); grid_blocks = -1; return; }
    int dev = 0, cus = 0, per_cu = 0;
    hipGetDevice(&dev);
    hipDeviceGetAttribute(&cus, hipDeviceAttributeMultiprocessorCount, dev);
    if (hipFuncSetAttribute((const void*)trunk_megakernel, hipFuncAttributeMaxDynamicSharedMemorySize, LDS_BYTES) != hipSuccess) {
      fprintf(stderr, "kernel_launch: hipFuncSetAttribute failed\n"); grid_blocks = -1; return;
    }
    hipOccupancyMaxActiveBlocksPerMultiprocessor(&per_cu, (const void*)trunk_megakernel, NT, LDS_BYTES);
    if (per_cu < 1) { fprintf(stderr, "kernel_launch: occupancy query returned %d\n", per_cu); per_cu = 1; }
    grid_blocks = cus * per_cu;
  }
  if (grid_blocks < 0) return;
  Params p{};
  p.x = (const float*)d_in[0]; p.meta = (const float*)d_in[1]; p.final_norm = (const float*)d_in[2];
  p.pool_norm = (const float*)d_in[3]; p.pool_w_in = (const float*)d_in[4]; p.pool_w_grp = (const float*)d_in[5];
  p.pool_scale = (const float*)d_in[6]; p.pool_w_out = (const float*)d_in[7]; p.gla_norm = (const float*)d_in[8];
  p.gla_w_in = (const float*)d_in[9]; p.gla_w_gate2 = (const float*)d_in[10]; p.gla_b_gate = (const float*)d_in[11];
  p.gla_head_norm = (const float*)d_in[12]; p.gla_w_out = (const float*)d_in[13];
  p.out = (float*)d_out; p.ws = (unsigned char*)d_ws;
  if (hipMemsetAsync((unsigned char*)d_ws + BAR_OFF, 0, 16384, stream) != hipSuccess) { fprintf(stderr, "kernel_launch: memset of barrier words failed\n"); return; }
  void* args[] = {&p};
  hipError_t e = hipLaunchCooperativeKernel((const void*)trunk_megakernel, dim3(grid_blocks), dim3(NT), args, LDS_BYTES, stream);
  if (e != hipSuccess) fprintf(stderr, "cooperative launch failed: %s (grid %d)\n", hipGetErrorString(e), grid_blocks);
}
```

```cpp
#include <hip/hip_runtime.h>
#include <hip/hip_cooperative_groups.h>
#include <cstdio>
namespace cg = cooperative_groups;

typedef unsigned short u16;
typedef unsigned int u32;
using bf16x8 = __attribute__((ext_vector_type(8))) short;
using f32x4 = __attribute__((ext_vector_type(4))) float;
#define DI __device__ __forceinline__

constexpr int NT = 512;
constexpr int DM = 1024, NB = 8, SEQ = 2048, NMETA = 16, TT = SEQ + NMETA, MR = NB * TT;
constexpr int DIN = 2048;
constexpr int NCH = 33, PADC = 48;
constexpr float EPS = 1e-6f;

constexpr size_t UNIT = (size_t)MR * 1024 * 2;
constexpr size_t H_OFF = 0;
constexpr size_t XN_OFF = 2 * UNIT;
constexpr size_t A_OFF = 3 * UNIT;
constexpr size_t B_OFF = 5 * UNIT;
constexpr size_t GLR_OFF = 7 * UNIT;
constexpr size_t G_OFF = GLR_OFF + (size_t)MR * 16 * 4;
constexpr size_t SSQ_OFF = G_OFF + (size_t)NB * NCH * 1024 * 4;
constexpr size_t BAR_OFF = SSQ_OFF + (size_t)MR * 4 * 16 * 4;
constexpr size_t PART_OFF = BAR_OFF + 16384;
constexpr size_t MPART_OFF = PART_OFF + (size_t)MR * 16 * 4;
constexpr size_t WUN_OFF = MPART_OFF + 16 * 64 * 4 + 65536;
constexpr size_t WS_END = WUN_OFF + (size_t)2 * 1024 * 2048 * 2;

constexpr size_t PW_SZ = 7340032, GW_SZ = 8519680;
constexpr size_t PW_IN = 0, PW_GRP = 4194304, PW_OUT = 5242880;
constexpr size_t GW_BASE = 2 * PW_SZ;
constexpr size_t GW_A = 0, GW_Z = 4325376, GW_OUT = 6422528;

constexpr int LDS_XB = 157696;
constexpr int LDS_BYTES = 157696 + 16;

#ifndef PROBE_SEL
#define PROBE_SEL -1
#endif
#define TICK(cat) do { if (PROBE_SEL >= 0) { const unsigned long long now_ = wall_clock64(); pacc[cat] += now_ - plast; plast = now_; } } while (0)
#define GSYNC(c) do { TICK(c); xcd_barrier(xb); TICK(6); } while (0)

struct Params {
  const float *x, *meta, *final_norm, *pool_norm, *pool_w_in, *pool_w_grp, *pool_scale, *pool_w_out,
      *gla_norm, *gla_w_in, *gla_w_gate2, *gla_b_gate, *gla_head_norm, *gla_w_out;
  float* out;
  unsigned char* ws;
};

extern __shared__ __attribute__((aligned(16))) unsigned char smem[];

DI u16 f2bf(float x) { u32 u = __float_as_uint(x); u += 0x7fffu + ((u >> 16) & 1u); return (u16)(u >> 16); }
DI float bf2f(u16 v) { return __uint_as_float(((u32)v) << 16); }
DI u32 pack2(float a, float b) { u32 r; asm("v_cvt_pk_bf16_f32 %0, %1, %2" : "=v"(r) : "v"(a), "v"(b)); return r; }
DI float bflo(u32 w) { return __uint_as_float(w << 16); }
DI float bfhi(u32 w) { return __uint_as_float(w & 0xffff0000u); }
DI float wave_sum(float v) {
#pragma unroll
  for (int o = 32; o > 0; o >>= 1) v += __shfl_xor(v, o);
  return v;
}
DI int opaque_tid() { int t = threadIdx.x; asm volatile("" : "+v"(t)); return t; }
DI float silu(float z) { return z * __builtin_amdgcn_rcpf(1.f + __expf(-z)); }

DI void cvt_job(const float* __restrict__ src, int ld, int coff, int K, int nvalid, int npad, u16* __restrict__ dst, const float* __restrict__ kscale = nullptr) {
  float* tile = (float*)smem;
  const int tid = opaque_tid();
  const int tk = K / 64, tn = npad / 64;
  const int c = tid & 63, rg = tid >> 6;
  const int ntile = tk * tn;
  float v[8];
  auto load_tile = [&](int t) {
    const int k0 = (t % tk) * 64, n0 = (t / tk) * 64;
    const int n = n0 + c;
#pragma unroll
    for (int i = 0; i < 8; ++i) v[i] = (n < nvalid) ? src[(size_t)(k0 + rg + i * 8) * ld + coff + n] : 0.f;
  };
  int t = blockIdx.x;
  if (t < ntile) load_tile(t);
  for (; t < ntile; t += gridDim.x) {
    const int k0 = (t % tk) * 64, n0 = (t / tk) * 64;
#pragma unroll
    for (int i = 0; i < 8; ++i) tile[(rg + i * 8) * 65 + c] = v[i];
    __syncthreads();
    if (t + (int)gridDim.x < ntile) load_tile(t + gridDim.x);
    const float ks = kscale ? kscale[k0 + c] : 1.f;
#pragma unroll
    for (int i = 0; i < 8; ++i) {
      const int n = rg + i * 8;
      dst[(size_t)(n0 + n) * K + k0 + c] = f2bf(tile[c * 65 + n] * ks);
    }
    __syncthreads();
  }
}

DI void cvt_phase(const Params& p) {
  u16* W = (u16*)p.out;
  for (int job = 0; job < 20; ++job) {
    if (job < 12) {
      const int j = job / 6, s = job % 6;
      u16* base = W + (size_t)j * PW_SZ;
      if (s == 0) {
        cvt_job(p.pool_w_in + (size_t)j * 1024 * 4096, 4096, 2048, 1024, 2048, 2048, base + PW_IN + (size_t)2048 * 1024, p.pool_norm + (size_t)j * DM);
        const float* wsrc = p.pool_w_in + (size_t)j * 1024 * 4096;
        const float* gk = p.pool_norm + (size_t)j * DM;
        u16* wun = (u16*)(p.ws + WUN_OFF) + (size_t)j * 1024 * 2048;
        for (int it = blockIdx.x * NT + threadIdx.x; it < 1024 * 512; it += gridDim.x * NT) {
          const int k = it >> 9, n4 = (it & 511) * 4;
          const float4 v = *(const float4*)(wsrc + (size_t)k * 4096 + n4);
          const float g = gk[k];
          uint2 o; o.x = pack2(v.x * g, v.y * g); o.y = pack2(v.z * g, v.w * g);
          *(uint2*)(wun + (size_t)k * 2048 + n4) = o;
        }
      }
      else if (s < 5) cvt_job(p.pool_w_grp + (size_t)(j * 4 + (s - 1)) * 512 * 512, 512, 0, 512, 512, 512, base + PW_GRP + (size_t)(s - 1) * 512 * 512);
      else cvt_job(p.pool_w_out + (size_t)j * 2048 * 1024, 1024, 0, 2048, 1024, 1024, base + PW_OUT);
    } else {
      const int jj = job - 12, j = jj / 4, s = jj % 4;
      u16* base = W + GW_BASE + (size_t)j * GW_SZ;
      const float* win = p.gla_w_in + (size_t)j * 1024 * 6160;
      const float* gn = p.gla_norm + (size_t)j * DM;
      if (s == 0) cvt_job(win, 6160, 0, 1024, 4096, 4096, base + GW_A, gn);
      else if (s == 1) cvt_job(win, 6160, 6144, 1024, 16, 128, base + GW_A + (size_t)4096 * 1024, gn);
      else if (s == 2) cvt_job(win, 6160, 4096, 1024, 2048, 2048, base + GW_Z, gn);
      else cvt_job(p.gla_w_out + (size_t)j * 2048 * 1024, 1024, 0, 2048, 1024, 1024, base + GW_OUT);
    }
  }
}

DI void norm_phase(const Params& p, int mode, const float* __restrict__ g) {
  const int tid = opaque_tid(), lane = tid & 63, wid = tid >> 6;
  u16* hb = (u16*)(p.ws + XN_OFF);
  float4 gv[4];
#pragma unroll
  for (int i = 0; i < 4; ++i) gv[i] = *(const float4*)(g + i * 256 + lane * 4);
  for (int r = blockIdx.x * 8 + wid; r < MR; r += gridDim.x * 8) {
    const int b = r / TT, t = r - b * TT;
    if (mode == 2 && t < NMETA) continue;
    float4 v[4];
    if (mode == 0) {
      const float* src = (t < NMETA) ? (p.meta + (size_t)t * 1024) : (p.x + ((size_t)b * SEQ + (t - NMETA)) * 1024);
#pragma unroll
      for (int i = 0; i < 4; ++i) {
        const float4 f = *(const float4*)(src + i * 256 + lane * 4);
        uint2 o; o.x = pack2(f.x, f.y); o.y = pack2(f.z, f.w);
        *(uint2*)(hb + (size_t)r * 1024 + i * 256 + lane * 4) = o;
        v[i].x = bflo(o.x); v[i].y = bfhi(o.x); v[i].z = bflo(o.y); v[i].w = bfhi(o.y);
      }
    } else {
#pragma unroll
      for (int i = 0; i < 4; ++i) {
        const uint2 o = *(const uint2*)(hb + (size_t)r * 1024 + i * 256 + lane * 4);
        v[i].x = bflo(o.x); v[i].y = bfhi(o.x); v[i].z = bflo(o.y); v[i].w = bfhi(o.y);
      }
    }
    float ss = 0.f;
#pragma unroll
    for (int i = 0; i < 4; ++i) ss += v[i].x * v[i].x + v[i].y * v[i].y + v[i].z * v[i].z + v[i].w * v[i].w;
    ss = wave_sum(ss);
    if (mode == 0) {
      if (lane < 16) ((float*)(p.ws + PART_OFF))[(size_t)r * 16 + lane] = (lane == 0) ? ss : 0.f;
      if (b == 0 && t < NMETA) ((float*)(p.ws + MPART_OFF))[t * 64 + lane] = (lane == 0) ? ss : 0.f;
    } else {
      const float rinv = rsqrtf(ss * (1.f / 1024.f) + EPS);
      float* dst = p.out + ((size_t)b * SEQ + (t - NMETA)) * 1024;
#pragma unroll
      for (int i = 0; i < 4; ++i) {
        float4 o;
        o.x = v[i].x * rinv * gv[i].x; o.y = v[i].y * rinv * gv[i].y;
        o.z = v[i].z * rinv * gv[i].z; o.w = v[i].w * rinv * gv[i].w;
        *(float4*)(dst + i * 256 + lane * 4) = o;
      }
    }
  }
}

template <int N> DI void wait_vm() { asm volatile("s_waitcnt vmcnt(%0)" ::"n"(N) : "memory"); }
#define SCHED_FENCE() __builtin_amdgcn_sched_barrier(0)
constexpr int G_STAGE = 65536;

DI void gemm_stage_part(const u16* __restrict__ A, int lda, const u16* __restrict__ Bt, int ldb, size_t arow0, int n0, int kcol, int bkcol, int buf, int tid, int rnd) {
  unsigned char* sa = smem + buf * G_STAGE;
  unsigned char* sb = sa + 32768;
  const int pidx = rnd * 512 + tid;
  const int r = pidx >> 3, cp = pidx & 7;
  const int kc = cp ^ ((r >> 1) & 7);
  const u16* gpa = A + (arow0 + r) * lda + kcol + kc * 8;
  __builtin_amdgcn_global_load_lds((const u32*)gpa, (__attribute__((address_space(3))) u32*)(sa + pidx * 16), 16, 0, 0);
  const u16* gpb = Bt + (size_t)(n0 + r) * ldb + bkcol + kc * 8;
  __builtin_amdgcn_global_load_lds((const u32*)gpb, (__attribute__((address_space(3))) u32*)(sb + pidx * 16), 16, 0, 0);
}

DI void tile_coords(int t, int ntn, int& mt, int& nt) {
  if ((ntn & 7) == 0) {
    const int npn = ntn >> 3, pidx = t >> 5, loc = t & 31;
    mt = (pidx / npn) * 4 + (loc >> 3);
    nt = (pidx % npn) * 8 + (loc & 7);
  } else { mt = t / ntn; nt = t - mt * ntn; }
}
template <class Epi>
DI void gemm_main(const u16* __restrict__ A, int lda, const u16* __restrict__ Bt, int K, int N, bool grouped, const Epi& epi, int lin_rows = 0, int ldb_ = 0, int lid_off = 0) {
  const int ldb = lin_rows ? ldb_ : K;
  const int tid = opaque_tid(), lane = tid & 63, wid = tid >> 6;
  const int wr = wid >> 2, wc = wid & 3, fr = lane & 15, fq = lane >> 4;
  const int ntn = N >> 8;
  const int ntiles = (lin_rows ? (lin_rows >> 8) : 64) * ntn;
  const int nk = K / 64;
  const int swz = (fr >> 1) & 7;
  const int kc0 = ((0 + fq) ^ swz) << 4, kc1 = ((4 + fq) ^ swz) << 4;
  const int arow = (wr * 128 + fr) * 128, brow = 32768 + (wc * 64 + fr) * 128;
  const int lid0 = ((int)gridDim.x % 8 == 0) ? (int)((blockIdx.x & 7) * (gridDim.x >> 3) + (blockIdx.x >> 3)) : (int)blockIdx.x;
  const int lid = (lid0 + (int)gridDim.x - lid_off) % (int)gridDim.x;
  for (int t = lid; t < ntiles; t += gridDim.x) {
    int mt, nt;
    tile_coords(t, ntn, mt, nt);
    const size_t m0 = lin_rows ? (size_t)mt * 256 : (size_t)(mt >> 3) * TT + NMETA + (mt & 7) * 256;
    const int n0 = nt * 256;
    const int akoff = grouped ? ((n0 >> 9) << 9) : 0;
    const int bko = lin_rows ? (((int)m0 >> 9) << 9) : 0;
    f32x4 acc[8][4];
#pragma unroll
    for (int i = 0; i < 8; ++i)
#pragma unroll
      for (int j = 0; j < 4; ++j) acc[i][j] = (f32x4){0.f, 0.f, 0.f, 0.f};
    if constexpr (Epi::kNeedRinv) {
      if (tid < 256) ((float*)(smem + 2 * G_STAGE))[tid] = epi.rs.rinv_main((int)m0 + tid);
    }
    if constexpr (Epi::kNeedRinv2) {
      if (tid >= 256) ((float*)(smem + 2 * G_STAGE + 1024))[tid - 256] = epi.row_scalar2((int)m0 + tid - 256, n0);
    }
    if (t == lid) {
#pragma unroll
      for (int q = 0; q < 4; ++q) gemm_stage_part(A, lda, Bt, ldb, m0, n0, akoff, bko, 0, tid, q);
    }
#pragma unroll 1
    for (int kt = 0; kt < nk; ++kt) {
      wait_vm<0>();
      __builtin_amdgcn_s_barrier();
      asm volatile("" ::: "memory");
      const bool pf = (kt + 1 < nk);
      const int pk = (kt + 1) * 64, pb = (kt + 1) & 1;
      const unsigned char* sbase = smem + (kt & 1) * G_STAGE;
#pragma unroll
      for (int ks = 0; ks < 2; ++ks) {
        const int kc = ks ? kc1 : kc0;
        bf16x8 bfr[4];
#pragma unroll
        for (int ni = 0; ni < 4; ++ni) bfr[ni] = *(const bf16x8*)(sbase + brow + kc + ni * 2048);
#pragma unroll
        for (int mh = 0; mh < 2; ++mh) {
          bf16x8 af[4];
#pragma unroll
          for (int mi = 0; mi < 4; ++mi) af[mi] = *(const bf16x8*)(sbase + arow + kc + (mh * 4 + mi) * 2048);
          if (pf) {
            if (ks == 0 && mh == 0) { gemm_stage_part(A, lda, Bt, ldb, m0, n0, akoff + pk, bko + pk, pb, tid, 0); gemm_stage_part(A, lda, Bt, ldb, m0, n0, akoff + pk, bko + pk, pb, tid, 1); }
            if (ks == 0 && mh == 1) { gemm_stage_part(A, lda, Bt, ldb, m0, n0, akoff + pk, bko + pk, pb, tid, 2); gemm_stage_part(A, lda, Bt, ldb, m0, n0, akoff + pk, bko + pk, pb, tid, 3); }
          }
          SCHED_FENCE();
#pragma unroll
          for (int mi = 0; mi < 4; ++mi)
#pragma unroll
            for (int ni = 0; ni < 4; ++ni)
              acc[mh * 4 + mi][ni] = __builtin_amdgcn_mfma_f32_16x16x32_bf16(bfr[ni], af[mi], acc[mh * 4 + mi][ni], 0, 0, 0);
          SCHED_FENCE();
        }
      }
    }
    {
      const int tn = t + (int)gridDim.x;
      if (tn < ntiles) {
        int mtn, ntn_;
        tile_coords(tn, ntn, mtn, ntn_);
        const size_t m0n = lin_rows ? (size_t)mtn * 256 : (size_t)(mtn >> 3) * TT + NMETA + (mtn & 7) * 256;
        const int n0n = ntn_ * 256;
        const int akn = grouped ? ((n0n >> 9) << 9) : 0;
        const int bkn = lin_rows ? (((int)m0n >> 9) << 9) : 0;
#pragma unroll
        for (int q = 0; q < 4; ++q) gemm_stage_part(A, lda, Bt, ldb, m0n, n0n, akn, bkn, 0, tid, q);
      }
    }
    {
      const bool odd = (fq & 1) != 0;
      const int colb = n0 + wc * 64 + (odd ? 16 + (fq - 1) * 4 : fq * 4);
#pragma unroll
      for (int hm = 0; hm < 2; ++hm) {
        typename Epi::Old old[4][2];
        float rtab[4], rowss[4];
#pragma unroll
        for (int m4 = 0; m4 < 4; ++m4) {
          rowss[m4] = 0.f;
          rtab[m4] = Epi::kNeedRinv ? ((const float*)(smem + 2 * G_STAGE))[wr * 128 + (hm * 4 + m4) * 16 + fr] : 1.f;
#pragma unroll
          for (int pr = 0; pr < 2; ++pr) old[m4][pr] = epi.load8((int)m0 + wr * 128 + (hm * 4 + m4) * 16 + fr, colb + pr * 32);
        }
#pragma unroll
        for (int m4 = 0; m4 < 4; ++m4)
#pragma unroll
          for (int pr = 0; pr < 2; ++pr) {
            const int mi = hm * 4 + m4;
            const f32x4 a = acc[mi][2 * pr], bq = acc[mi][2 * pr + 1];
            float v[8];
#pragma unroll
            for (int e2 = 0; e2 < 4; ++e2) {
              const float send = odd ? a[e2] : bq[e2];
              const float recv = __shfl_xor(send, 16);
              v[e2] = odd ? recv : a[e2];
              v[4 + e2] = odd ? bq[e2] : recv;
            }
            if constexpr (Epi::kNeedRinv2) rowss[m4] += epi.op8x((int)m0 + wr * 128 + mi * 16 + fr, colb + pr * 32, v, old[m4][pr], rtab[m4], ((const float*)(smem + 2 * G_STAGE + 1024))[wr * 128 + mi * 16 + fr]);
            else rowss[m4] += epi.op8((int)m0 + wr * 128 + mi * 16 + fr, colb + pr * 32, v, old[m4][pr], rtab[m4]);
          }
        if constexpr (Epi::kRowStat) {
#pragma unroll
          for (int m4 = 0; m4 < 4; ++m4) {
            float ss = rowss[m4];
            ss += __shfl_xor(ss, 16);
            ss += __shfl_xor(ss, 32);
            if (fq == 0) epi.row_done_main((int)m0 + wr * 128 + (hm * 4 + m4) * 16 + fr, nt * 4 + wc, ss);
          }
        }
      }
    }
    if (t + (int)gridDim.x < ntiles) {
      wait_vm<0>();
      __syncthreads();
    } else {
      asm volatile("s_waitcnt lgkmcnt(0)" ::: "memory");
      __builtin_amdgcn_s_barrier();
      asm volatile("" ::: "memory");
    }
  }
}

template <int K, class Epi>
DI void gemm_mini(const u16* __restrict__ A, int lda, const u16* __restrict__ Bt, int N, bool grouped, const Epi& epi, int glr_rows) {
  const int tid = opaque_tid(), lane = tid & 63, wid = tid >> 6;
  const int fr = lane & 15, fq = lane >> 4;
  constexpr int KW = K / 8;
  constexpr int KS = KW / 32;
  f32x4* red = (f32x4*)smem;
  for (int it = blockIdx.x; it < (N >> 4); it += gridDim.x) {
    const int n0 = it * 16;
    const int akoff = grouped ? ((n0 >> 9) << 9) : 0;
    const auto pre = epi.pre4(wid * TT + fr, n0 + fq * 4);
    const u16* wp = Bt + (size_t)(n0 + fr) * K + wid * KW + fq * 8;
    const u16* xp = A + (size_t)fr * lda + akoff + wid * KW + fq * 8;
    bf16x8 wf[KS], xf[KS];
#pragma unroll
    for (int s = 0; s < KS; ++s) { wf[s] = *(const bf16x8*)(wp + s * 32); xf[s] = *(const bf16x8*)(xp + s * 32); }
    f32x4 acc = (f32x4){0.f, 0.f, 0.f, 0.f};
#pragma unroll
    for (int s = 0; s < KS; ++s) acc = __builtin_amdgcn_mfma_f32_16x16x32_bf16(wf[s], xf[s], acc, 0, 0, 0);
    red[wid * 64 + lane] = acc;
    __syncthreads();
    f32x4 tot = red[lane];
#pragma unroll
    for (int w = 1; w < 8; ++w) { const f32x4 t = red[w * 64 + lane]; tot[0] += t[0]; tot[1] += t[1]; tot[2] += t[2]; tot[3] += t[3]; }
    {
      float ss = epi.app4(wid * TT + fr, n0 + fq * 4, tot, pre);
      if constexpr (Epi::kRowStat) {
        ss += __shfl_xor(ss, 16);
        ss += __shfl_xor(ss, 32);
        if (wid == 0 && fq == 0) epi.row_done_meta(fr, it, ss);
      }
    }
    asm volatile("s_waitcnt lgkmcnt(0)" ::: "memory");
    __builtin_amdgcn_s_barrier();
    asm volatile("" ::: "memory");
  }
  if (glr_rows > 0) {
    bf16x8 wf[KS];
#pragma unroll
    for (int s = 0; s < KS; ++s) wf[s] = *(const bf16x8*)(Bt + (size_t)(N + fr) * K + wid * KW + s * 32 + fq * 8);
    for (int base = blockIdx.x; base < glr_rows; base += 5 * gridDim.x) {
      const int itw = base + (wid < 5 ? wid : 0) * (int)gridDim.x;
      const auto pre = epi.pre4((itw < glr_rows ? itw : base) * 16 + fr, N + fq * 4);
      bf16x8 xf[5][KS];
#pragma unroll
      for (int r = 0; r < 5; ++r) {
        const int it = base + r * gridDim.x;
        const int itc = (it < glr_rows) ? it : base;
#pragma unroll
        for (int s = 0; s < KS; ++s) xf[r][s] = *(const bf16x8*)(A + (size_t)(itc * 16 + fr) * lda + wid * KW + s * 32 + fq * 8);
      }
#pragma unroll
      for (int r = 0; r < 5; ++r) {
        f32x4 acc = (f32x4){0.f, 0.f, 0.f, 0.f};
#pragma unroll
        for (int s = 0; s < KS; ++s) acc = __builtin_amdgcn_mfma_f32_16x16x32_bf16(wf[s], xf[r][s], acc, 0, 0, 0);
        red[(r * 8 + wid) * 64 + lane] = acc;
      }
      __syncthreads();
      if (wid < 5) {
        const int it = base + wid * gridDim.x;
        if (it < glr_rows) {
          f32x4 tot = red[(wid * 8) * 64 + lane];
#pragma unroll
          for (int w = 1; w < 8; ++w) { const f32x4 t = red[(wid * 8 + w) * 64 + lane]; tot[0] += t[0]; tot[1] += t[1]; tot[2] += t[2]; tot[3] += t[3]; }
          epi.app4(it * 16 + fr, N + fq * 4, tot, pre);
        }
      }
      __syncthreads();
    }
  }
}

struct RowStat {
  const float* part; const float* mpart;
  DI float rinv_main(int row) const {
    const float4* sp = (const float4*)(part + (size_t)row * 16);
    float s = 0.f;
#pragma unroll
    for (int i = 0; i < 4; ++i) { const float4 t = sp[i]; s += t.x + t.y + t.z + t.w; }
    return rsqrtf(s * (1.f / 1024.f) + EPS);
  }
  DI float rinv_any(int row) const {
    const int t = row % TT;
    if (t >= NMETA) return rinv_main(row);
    const float4* sp = (const float4*)(mpart + t * 64);
    float s = 0.f;
#pragma unroll
    for (int i = 0; i < 16; ++i) { const float4 q = sp[i]; s += q.x + q.y + q.z + q.w; }
    return rsqrtf(s * (1.f / 1024.f) + EPS);
  }
};
DI uint4 pack8(const float (&v)[8]) { uint4 o; o.x = pack2(v[0], v[1]); o.y = pack2(v[2], v[3]); o.z = pack2(v[4], v[5]); o.w = pack2(v[6], v[7]); return o; }
struct EpiPlainBf16 {
  static constexpr bool kRowStat = false, kNeedRinv = false, kNeedRinv2 = false;
  u16* out; int ld; RowStat rs;
  typedef int Old;
  DI Old load8(int, int) const { return 0; }
  DI float op8(int row, int col, const float (&v)[8], const Old&, float) const { *(uint4*)(out + (size_t)row * ld + col) = pack8(v); return 0.f; }
};
struct EpiPoolIn {
  static constexpr bool kRowStat = false, kNeedRinv = true, kNeedRinv2 = false;
  u16* va; u16* sz; RowStat rs;
  typedef int Old;
  DI Old load8(int, int) const { return 0; }
  DI float op8(int row, int col, const float (&v)[8], const Old&, float r) const {
    if (col < DIN) {
      const float w[8] = {v[0] * r, v[1] * r, v[2] * r, v[3] * r, v[4] * r, v[5] * r, v[6] * r, v[7] * r};
      *(uint4*)(va + (size_t)row * DIN + col) = pack8(w);
    } else {
      const float w[8] = {silu(v[0] * r), silu(v[1] * r), silu(v[2] * r), silu(v[3] * r), silu(v[4] * r), silu(v[5] * r), silu(v[6] * r), silu(v[7] * r)};
      *(uint4*)(sz + (size_t)row * DIN + (col - DIN)) = pack8(w);
    }
    return 0.f;
  }
  struct Pre4 { float r; };
  DI Pre4 pre4(int row, int) const { Pre4 q; q.r = rs.rinv_any(row); return q; }
  DI float app4(int row, int col, f32x4 v, const Pre4& q) const {
    uint2 o;
    if (col < DIN) {
      o.x = pack2(v[0] * q.r, v[1] * q.r); o.y = pack2(v[2] * q.r, v[3] * q.r);
      *(uint2*)(va + (size_t)row * DIN + col) = o;
    } else {
      o.x = pack2(silu(v[0] * q.r), silu(v[1] * q.r)); o.y = pack2(silu(v[2] * q.r), silu(v[3] * q.r));
      *(uint2*)(sz + (size_t)row * DIN + (col - DIN)) = o;
    }
    return 0.f;
  }
};
struct EpiStoreBf16 {
  static constexpr bool kRowStat = false, kNeedRinv = true, kNeedRinv2 = false;
  u16* out; int ld; RowStat rs;
  typedef int Old;
  DI Old load8(int, int) const { return 0; }
  DI float op8(int row, int col, const float (&v)[8], const Old&, float r) const {
    const float w[8] = {v[0] * r, v[1] * r, v[2] * r, v[3] * r, v[4] * r, v[5] * r, v[6] * r, v[7] * r};
    *(uint4*)(out + (size_t)row * ld + col) = pack8(w);
    return 0.f;
  }
  struct Pre4 { float r; };
  DI Pre4 pre4(int row, int) const { Pre4 q; q.r = rs.rinv_any(row); return q; }
  DI float app4(int row, int col, f32x4 v, const Pre4& q) const {
    uint2 o; o.x = pack2(v[0] * q.r, v[1] * q.r); o.y = pack2(v[2] * q.r, v[3] * q.r);
    *(uint2*)(out + (size_t)row * ld + col) = o;
    return 0.f;
  }
};
struct EpiScaleBf16 {
  static constexpr bool kRowStat = false, kNeedRinv = false, kNeedRinv2 = false;
  u16* out; const float* scale; RowStat rs;
  typedef int Old;
  DI Old load8(int, int) const { return 0; }
  DI float op8(int row, int col, const float (&v)[8], const Old&, float) const {
    const float4 s0 = *(const float4*)(scale + col), s1 = *(const float4*)(scale + col + 4);
    const float w[8] = {v[0] * s0.x, v[1] * s0.y, v[2] * s0.z, v[3] * s0.w, v[4] * s1.x, v[5] * s1.y, v[6] * s1.z, v[7] * s1.w};
    *(uint4*)(out + (size_t)row * DIN + col) = pack8(w);
    return 0.f;
  }
  struct Pre4 { float4 s; };
  DI Pre4 pre4(int, int col) const { Pre4 q; q.s = *(const float4*)(scale + col); return q; }
  DI float app4(int row, int col, f32x4 v, const Pre4& q) const {
    uint2 o; o.x = pack2(v[0] * q.s.x, v[1] * q.s.y); o.y = pack2(v[2] * q.s.z, v[3] * q.s.w);
    *(uint2*)(out + (size_t)row * DIN + col) = o;
    return 0.f;
  }
};
struct EpiGateInplace {
  static constexpr bool kRowStat = false, kNeedRinv = true, kNeedRinv2 = false;
  u16* y; RowStat rs;
  typedef uint4 Old;
  DI Old load8(int row, int col) const { return *(const uint4*)(y + (size_t)row * DIN + col); }
  DI float op8(int row, int col, const float (&v)[8], const Old& yv, float r) const {
    const float w[8] = {bflo(yv.x) * silu(v[0] * r), bfhi(yv.x) * silu(v[1] * r), bflo(yv.y) * silu(v[2] * r), bfhi(yv.y) * silu(v[3] * r),
                        bflo(yv.z) * silu(v[4] * r), bfhi(yv.z) * silu(v[5] * r), bflo(yv.w) * silu(v[6] * r), bfhi(yv.w) * silu(v[7] * r)};
    *(uint4*)(y + (size_t)row * DIN + col) = pack8(w);
    return 0.f;
  }
  struct Pre4 { float r; uint2 yv; };
  DI Pre4 pre4(int row, int col) const { Pre4 q; q.r = rs.rinv_any(row); q.yv = *(const uint2*)(y + (size_t)row * DIN + col); return q; }
  DI float app4(int row, int col, f32x4 v, const Pre4& q) const {
    uint2 o;
    o.x = pack2(bflo(q.yv.x) * silu(v[0] * q.r), bfhi(q.yv.x) * silu(v[1] * q.r));
    o.y = pack2(bflo(q.yv.y) * silu(v[2] * q.r), bfhi(q.yv.y) * silu(v[3] * q.r));
    *(uint2*)(y + (size_t)row * DIN + col) = o;
    return 0.f;
  }
};
struct EpiResidual {
  static constexpr bool kRowStat = true, kNeedRinv = false, kNeedRinv2 = false;
  u16* hb; float* part; float* mpart; RowStat rs;
  typedef uint4 Old;
  DI Old load8(int row, int col) const { return *(const uint4*)(hb + (size_t)row * DM + col); }
  DI float op8(int row, int col, const float (&v)[8], const Old& hv, float) const {
    uint4 o;
    o.x = pack2(bflo(hv.x) + v[0], bfhi(hv.x) + v[1]); o.y = pack2(bflo(hv.y) + v[2], bfhi(hv.y) + v[3]);
    o.z = pack2(bflo(hv.z) + v[4], bfhi(hv.z) + v[5]); o.w = pack2(bflo(hv.w) + v[6], bfhi(hv.w) + v[7]);
    *(uint4*)(hb + (size_t)row * DM + col) = o;
    const float a0 = bflo(o.x), a1 = bfhi(o.x), a2 = bflo(o.y), a3 = bfhi(o.y), a4 = bflo(o.z), a5 = bfhi(o.z), a6 = bflo(o.w), a7 = bfhi(o.w);
    return a0 * a0 + a1 * a1 + a2 * a2 + a3 * a3 + a4 * a4 + a5 * a5 + a6 * a6 + a7 * a7;
  }
  struct Pre4 { uint2 hv; };
  DI Pre4 pre4(int row, int col) const { Pre4 q; q.hv = *(const uint2*)(hb + (size_t)row * DM + col); return q; }
  DI float app4(int row, int col, f32x4 v, const Pre4& q) const {
    const uint2 hv = q.hv;
    uint2 o; o.x = pack2(bflo(hv.x) + v[0], bfhi(hv.x) + v[1]); o.y = pack2(bflo(hv.y) + v[2], bfhi(hv.y) + v[3]);
    *(uint2*)(hb + (size_t)row * DM + col) = o;
    const float a0 = bflo(o.x), a1 = bfhi(o.x), a2 = bflo(o.y), a3 = bfhi(o.y);
    return a0 * a0 + a1 * a1 + a2 * a2 + a3 * a3;
  }
  DI void row_done_main(int row, int slot, float ss) const { part[(size_t)row * 16 + slot] = ss; }
  DI void row_done_meta(int t, int slot, float ss) const { mpart[t * 64 + slot] = ss; }
};
struct EpiQKV {
  static constexpr bool kRowStat = false, kNeedRinv = true, kNeedRinv2 = false;
  u16 *q, *k, *v; float* glr; RowStat rs;
  typedef int Old;
  DI Old load8(int, int) const { return 0; }
  DI float op8(int row, int col, const float (&a)[8], const Old&, float r) const {
    const float w[8] = {a[0] * r, a[1] * r, a[2] * r, a[3] * r, a[4] * r, a[5] * r, a[6] * r, a[7] * r};
    u16* dst;
    if (col < 1024) dst = q + (size_t)row * 1024 + col;
    else if (col < 2048) dst = k + (size_t)row * 1024 + (col - 1024);
    else dst = v + (size_t)row * DIN + (col - 2048);
    *(uint4*)dst = pack8(w);
    return 0.f;
  }
  struct Pre4 { float r; };
  DI Pre4 pre4(int row, int) const { Pre4 pq; pq.r = rs.rinv_any(row); return pq; }
  DI float app4(int row, int col, f32x4 a, const Pre4& pq) const {
    const float r = pq.r;
    if (col < 4096) {
      uint2 o; o.x = pack2(a[0] * r, a[1] * r); o.y = pack2(a[2] * r, a[3] * r);
      u16* dst;
      if (col < 1024) dst = q + (size_t)row * 1024 + col;
      else if (col < 2048) dst = k + (size_t)row * 1024 + (col - 1024);
      else dst = v + (size_t)row * DIN + (col - 2048);
      *(uint2*)dst = o;
    } else if (col < 4112) {
      float4 o; o.x = a[0] * r; o.y = a[1] * r; o.z = a[2] * r; o.w = a[3] * r;
      *(float4*)(glr + (size_t)row * 16 + (col - 4096)) = o;
    }
    return 0.f;
  }
};
struct EpiGlaGate {
  static constexpr bool kRowStat = false, kNeedRinv = true, kNeedRinv2 = true;
  u16* o; const float* ssq; const float* hn; RowStat rs;
  typedef uint4 Old;
  DI float head_rinv(int row, int col) const {
    const int head = col >> 9;
    const float4* sp = (const float4*)(ssq + ((size_t)row * 4 + head) * 16);
    float s = 0.f;
#pragma unroll
    for (int i = 0; i < 4; ++i) { const float4 t = sp[i]; s += t.x + t.y + t.z + t.w; }
    return rsqrtf(s * (1.f / 512.f) + EPS);
  }
  DI float row_scalar2(int row, int col) const { return head_rinv(row, col); }
  DI Old load8(int row, int col) const { return *(const uint4*)(o + (size_t)row * DIN + col); }
  DI float op8x(int row, int col, const float (&z)[8], const Old& ov, float r, float rinv) const {
    const float4 g0 = *(const float4*)(hn + col), g1 = *(const float4*)(hn + col + 4);
    const float w[8] = {bflo(ov.x) * rinv * g0.x * silu(z[0] * r), bfhi(ov.x) * rinv * g0.y * silu(z[1] * r),
                        bflo(ov.y) * rinv * g0.z * silu(z[2] * r), bfhi(ov.y) * rinv * g0.w * silu(z[3] * r),
                        bflo(ov.z) * rinv * g1.x * silu(z[4] * r), bfhi(ov.z) * rinv * g1.y * silu(z[5] * r),
                        bflo(ov.w) * rinv * g1.z * silu(z[6] * r), bfhi(ov.w) * rinv * g1.w * silu(z[7] * r)};
    *(uint4*)(o + (size_t)row * DIN + col) = pack8(w);
    return 0.f;
  }
  struct Pre4 { float r, rinv; uint2 ov; float4 g; };
  DI Pre4 pre4(int row, int col) const {
    Pre4 q; q.rinv = head_rinv(row, col); q.r = rs.rinv_any(row); q.g = *(const float4*)(hn + col);
    q.ov = *(const uint2*)(o + (size_t)row * DIN + col); return q;
  }
  DI float app4(int row, int col, f32x4 z, const Pre4& q) const {
    const float rinv = q.rinv, r = q.r;
    const float4 g = q.g;
    uint2* ptr = (uint2*)(o + (size_t)row * DIN + col);
    const uint2 ov = q.ov;
    uint2 w;
    w.x = pack2(bflo(ov.x) * rinv * g.x * silu(z[0] * r), bfhi(ov.x) * rinv * g.y * silu(z[1] * r));
    w.y = pack2(bflo(ov.y) * rinv * g.z * silu(z[2] * r), bfhi(ov.y) * rinv * g.w * silu(z[3] * r));
    *ptr = w;
    return 0.f;
  }
};

DI void unpack8(const uint4& v, float (&f)[8]) {
  f[0] = bflo(v.x); f[1] = bfhi(v.x); f[2] = bflo(v.y); f[3] = bfhi(v.y); f[4] = bflo(v.z); f[5] = bfhi(v.z); f[6] = bflo(v.w); f[7] = bfhi(v.w);
}
template <int W>
DI void pool_run(const u16* __restrict__ U, u16* Tb, const float* __restrict__ scale, size_t rbase, int p0, int c0) {
  const float4 s0 = *(const float4*)(scale + c0), s1 = *(const float4*)(scale + c0 + 4);
  uint4 cur[8], prev[W];
#pragma unroll
  for (int i = 0; i < 8; ++i) cur[i] = *(const uint4*)(U + (rbase + i) * DIN + c0);
#pragma unroll
  for (int j = 0; j < W; ++j) {
    prev[j] = make_uint4(0, 0, 0, 0);
    if (p0 - W + j >= 0) prev[j] = *(const uint4*)(U + (rbase - W + j) * DIN + c0);
  }
  float sum[8];
#pragma unroll
  for (int e2 = 0; e2 < 8; ++e2) sum[e2] = 0.f;
#pragma unroll
  for (int j = 0; j < W; ++j) {
    float f[8]; unpack8(prev[j], f);
#pragma unroll
    for (int e2 = 0; e2 < 8; ++e2) sum[e2] += f[e2];
  }
#pragma unroll
  for (int i = 0; i < 8; ++i) {
    float c[8], o[8];
    unpack8(cur[i], c);
    unpack8((i < W) ? prev[i < W ? i : 0] : cur[i >= W ? i - W : 0], o);
#pragma unroll
    for (int e2 = 0; e2 < 8; ++e2) sum[e2] += c[e2] - o[e2];
    const float inv = __builtin_amdgcn_rcpf((float)min(p0 + i + 1, W));
    uint4 r;
    float gz[8];
    unpack8(*(const uint4*)(Tb + (rbase + i) * DIN + c0), gz);
    r.x = pack2((sum[0] * inv - c[0]) * s0.x * gz[0], (sum[1] * inv - c[1]) * s0.y * gz[1]);
    r.y = pack2((sum[2] * inv - c[2]) * s0.z * gz[2], (sum[3] * inv - c[3]) * s0.w * gz[3]);
    r.z = pack2((sum[4] * inv - c[4]) * s1.x * gz[4], (sum[5] * inv - c[5]) * s1.y * gz[5]);
    r.w = pack2((sum[6] * inv - c[6]) * s1.z * gz[6], (sum[7] * inv - c[7]) * s1.w * gz[7]);
    *(uint4*)(Tb + (rbase + i) * DIN + c0) = r;
  }
}
DI void pool_phase(const u16* __restrict__ U, u16* Tb, const float* __restrict__ scale) {
  const int total = (MR / 8) * 256;
  const int ptid = opaque_tid();
  for (int it = blockIdx.x * NT + ptid; it < total; it += gridDim.x * NT) {
    const int cgp = it & 255, run = it >> 8;
    const int c0 = cgp * 8;
    const int g = c0 >> 9;
    const int b = run / 258, p0 = (run - b * 258) * 8;
    const size_t rbase = (size_t)b * TT + p0;
    if (g == 0) pool_run<2>(U, Tb, scale, rbase, p0, c0);
    else if (g == 1) pool_run<4>(U, Tb, scale, rbase, p0, c0);
    else if (g == 2) pool_run<8>(U, Tb, scale, rbase, p0, c0);
    else pool_run<16>(U, Tb, scale, rbase, p0, c0);
  }
}

DI float logsig(float x) { return fminf(x, 0.f) - __logf(1.f + __expf(-fabsf(x))); }

DI void gla_prep_phase(const Params& p, int j) {
  u16* Q = (u16*)(p.ws + A_OFF);
  u16* Kb = (u16*)(p.ws + A_OFF + UNIT);
  const float* GLR = (const float*)(p.ws + GLR_OFF);
  float* G = (float*)(p.ws + G_OFF);
  const float* w2 = p.gla_w_gate2 + (size_t)j * 16 * 1024;
  const float* bg = p.gla_b_gate + (size_t)j * 1024;
  const int tid = opaque_tid();
  const int col = tid * 2;
  float* gl = (float*)smem;
  float wa[16], wb[16];
#pragma unroll
  for (int k = 0; k < 16; ++k) { const float2 t = *(const float2*)(w2 + k * 1024 + col); wa[k] = t.x; wb[k] = t.y; }
  const float2 bb = *(const float2*)(bg + col);
  const int nfull = NB * (NCH - 1);
  for (int it = blockIdx.x; it < NB * NCH; it += gridDim.x) {
    int b, c;
    if (it < nfull) { b = it >> 5; c = (it & 31) + 1; } else { b = it - nfull; c = 0; }
    const int i0 = (c == 0) ? PADC : 0;
    const size_t row0 = (size_t)b * TT + (c * 64 - PADC);
    __syncthreads();
    for (int e2 = tid; e2 < (64 - i0) * 16; e2 += NT) gl[i0 * 16 + e2] = GLR[(row0 + i0) * 16 + e2];
    __syncthreads();
    float cuma = 0.f, cumb = 0.f;
    u32 qn[8], kn[8];
#pragma unroll
    for (int r = 0; r < 8; ++r) {
      qn[r] = *(const u32*)(Q + (row0 + i0 + r) * 1024 + col);
      kn[r] = *(const u32*)(Kb + (row0 + i0 + r) * 1024 + col);
    }
    for (int ib = i0; ib < 64; ib += 8) {
      u32 qv[8], kv[8];
#pragma unroll
      for (int r = 0; r < 8; ++r) { qv[r] = qn[r]; kv[r] = kn[r]; }
      if (ib + 8 < 64) {
#pragma unroll
        for (int r = 0; r < 8; ++r) {
          qn[r] = *(const u32*)(Q + (row0 + ib + 8 + r) * 1024 + col);
          kn[r] = *(const u32*)(Kb + (row0 + ib + 8 + r) * 1024 + col);
        }
      }
#pragma unroll
      for (int r = 0; r < 8; ++r) {
        const float4* gp = (const float4*)(gl + (ib + r) * 16);
        const float4 g0 = gp[0], g1 = gp[1], g2 = gp[2], g3 = gp[3];
        const float gx[16] = {g0.x, g0.y, g0.z, g0.w, g1.x, g1.y, g1.z, g1.w, g2.x, g2.y, g2.z, g2.w, g3.x, g3.y, g3.z, g3.w};
        float xa = bb.x, xb = bb.y;
#pragma unroll
        for (int k = 0; k < 16; ++k) { xa += gx[k] * wa[k]; xb += gx[k] * wb[k]; }
        cuma += logsig(xa) * (1.f / 16.f);
        cumb += logsig(xb) * (1.f / 16.f);
        const float ea = __expf(cuma), eb = __expf(cumb);
        *(u32*)(Q + (row0 + ib + r) * 1024 + col) = pack2(bflo(qv[r]) * ea * 0.0625f, bfhi(qv[r]) * eb * 0.0625f);
        *(u32*)(Kb + (row0 + ib + r) * 1024 + col) = pack2(bflo(kv[r]) * __expf(-cuma), bfhi(kv[r]) * __expf(-cumb));
      }
    }
    float2 go; go.x = __expf(cuma); go.y = __expf(cumb);
    *(float2*)(G + ((size_t)(b * NCH + c)) * 1024 + col) = go;
  }
  __syncthreads();
}

constexpr int L_QE = 0, L_KE = 33792, L_ST = 67584, L_V = 101376, L_ATT = 110592, L_GL = 119808;
constexpr int RS_W = 528, RS_N = 144;
typedef short s16x4 __attribute__((ext_vector_type(4)));
DI bf16x8 tr_frag(const unsigned char* img, int rstride, int k0, int c0, int lane) {
  const int i = lane & 15, g = lane >> 4, q = i >> 2, pp = i & 3;
  const unsigned char* a0 = img + (k0 + 8 * g + q) * rstride + (c0 + 4 * pp) * 2;
  const s16x4 lo = __builtin_amdgcn_ds_read_tr16_b64_v4i16((__attribute__((address_space(3))) s16x4*)a0);
  const s16x4 hi = __builtin_amdgcn_ds_read_tr16_b64_v4i16((__attribute__((address_space(3))) s16x4*)(a0 + 4 * rstride));
  return __builtin_shufflevector(lo, hi, 0, 1, 2, 3, 4, 5, 6, 7);
}

DI void gla_scan_phase(const Params& p) {
  const u16* Q = (const u16*)(p.ws + A_OFF);
  const u16* Kb = (const u16*)(p.ws + A_OFF + UNIT);
  u16* V = (u16*)(p.ws + B_OFF);
  const float* G = (const float*)(p.ws + G_OFF);
  float* SSQ = (float*)(p.ws + SSQ_OFF);
  const int tid = opaque_tid(), lane = tid & 63, wid = tid >> 6, fr = lane & 15, fq = lane >> 4;
  for (int item = blockIdx.x; item < 256; item += gridDim.x) {
    const int b = item >> 5, hh = (item >> 3) & 3, eb = item & 7;
    f32x4 S[2][4];
#pragma unroll
    for (int x = 0; x < 2; ++x)
#pragma unroll
      for (int e = 0; e < 4; ++e) S[x][e] = (f32x4){0.f, 0.f, 0.f, 0.f};
    uint4 pq[4], pk[4], pv;
    float pg = 0.f;
    auto prefetch = [&](int c) {
#pragma unroll
      for (int rr = 0; rr < 4; ++rr) {
        const int pidx = tid + 512 * rr;
        const int i = pidx >> 5, cc = pidx & 31;
        const int t = c * 64 - PADC + i;
        pq[rr] = make_uint4(0, 0, 0, 0); pk[rr] = make_uint4(0, 0, 0, 0);
        if (t >= 0) {
          const size_t off = ((size_t)b * TT + t) * 1024 + hh * 256 + cc * 8;
          pq[rr] = *(const uint4*)(Q + off);
          pk[rr] = *(const uint4*)(Kb + off);
        }
      }
      {
        const int i = tid >> 3, cc = tid & 7;
        const int t = c * 64 - PADC + i;
        pv = make_uint4(0, 0, 0, 0);
        if (t >= 0) pv = *(const uint4*)(V + ((size_t)b * TT + t) * DIN + hh * 512 + eb * 64 + cc * 8);
      }
      if (tid < 256) pg = G[((size_t)(b * NCH + c)) * 1024 + hh * 256 + tid];
    };
    prefetch(0);
    for (int c = 0; c < NCH; ++c) {
      {
#pragma unroll
        for (int rr = 0; rr < 4; ++rr) {
          const int pidx = tid + 512 * rr;
          const int i = pidx >> 5, cc = pidx & 31;
          *(uint4*)(smem + L_QE + i * RS_W + cc * 16) = pq[rr];
          *(uint4*)(smem + L_KE + i * RS_W + cc * 16) = pk[rr];
        }
        {
          const int i = tid >> 3, cc = tid & 7;
          *(uint4*)(smem + L_V + i * RS_N + cc * 16) = pv;
        }
        if (tid < 256) *(float*)(smem + L_GL + tid * 4) = pg;
#pragma unroll
        for (int x = 0; x < 2; ++x)
#pragma unroll
          for (int e = 0; e < 4; ++e) {
            uint2 o; o.x = pack2(S[x][e][0], S[x][e][1]); o.y = pack2(S[x][e][2], S[x][e][3]);
            *(uint2*)(smem + L_ST + (e * 16 + fr) * RS_W + ((wid * 2 + x) * 16 + fq * 4) * 2) = o;
          }
      }
      __syncthreads();
      if (c + 1 < NCH) prefetch(c + 1);
      {
#pragma unroll
        for (int x = 0; x < 2; ++x) {
          const int f = wid * 2 + x, sf = f >> 2, tf = f & 3;
          f32x4 acc = (f32x4){0.f, 0.f, 0.f, 0.f};
          if (sf <= tf) {
            bf16x8 ka[8], qb[8];
#pragma unroll
            for (int ks = 0; ks < 8; ++ks) {
              ka[ks] = *(const bf16x8*)(smem + L_KE + (sf * 16 + fr) * RS_W + (ks * 4 + fq) * 16);
              qb[ks] = *(const bf16x8*)(smem + L_QE + (tf * 16 + fr) * RS_W + (ks * 4 + fq) * 16);
            }
            SCHED_FENCE();
#pragma unroll
            for (int ks = 0; ks < 8; ++ks) acc = __builtin_amdgcn_mfma_f32_16x16x32_bf16(ka[ks], qb[ks], acc, 0, 0, 0);
            SCHED_FENCE();
            const int tcol = tf * 16 + fr;
#pragma unroll
            for (int jj = 0; jj < 4; ++jj) if (sf * 16 + fq * 4 + jj > tcol) acc[jj] = 0.f;
          }
          uint2 o; o.x = pack2(acc[0], acc[1]); o.y = pack2(acc[2], acc[3]);
          *(uint2*)(smem + L_ATT + (tf * 16 + fr) * RS_N + (sf * 16 + fq * 4) * 2) = o;
        }
#pragma unroll
        for (int ks = 0; ks < 2; ++ks) {
          bf16x8 ka[2], vb[4];
#pragma unroll
          for (int x = 0; x < 2; ++x) ka[x] = tr_frag(smem + L_KE, RS_W, ks * 32, (wid * 2 + x) * 16, lane);
#pragma unroll
          for (int e = 0; e < 4; ++e) vb[e] = tr_frag(smem + L_V, RS_N, ks * 32, e * 16, lane);
#pragma unroll
          for (int x = 0; x < 2; ++x)
#pragma unroll
            for (int e = 0; e < 4; ++e) S[x][e] = __builtin_amdgcn_mfma_f32_16x16x32_bf16(ka[x], vb[e], S[x][e], 0, 0, 0);
        }
#pragma unroll
        for (int x = 0; x < 2; ++x) {
          const float4 gv = *(const float4*)(smem + L_GL + ((wid * 2 + x) * 16 + fq * 4) * 4);
#pragma unroll
          for (int e = 0; e < 4; ++e) { S[x][e][0] *= gv.x; S[x][e][1] *= gv.y; S[x][e][2] *= gv.z; S[x][e][3] *= gv.w; }
        }
      }
      __syncthreads();
      {
        const int tf = wid >> 1;
        f32x4 oacc[2];
        oacc[0] = (f32x4){0.f, 0.f, 0.f, 0.f}; oacc[1] = oacc[0];
#pragma unroll
        for (int ks = 0; ks < 2; ++ks) {
          const bf16x8 ab = *(const bf16x8*)(smem + L_ATT + (tf * 16 + fr) * RS_N + (ks * 4 + fq) * 16);
#pragma unroll
          for (int y = 0; y < 2; ++y) {
            const int ef = (wid & 1) * 2 + y;
            const bf16x8 va = tr_frag(smem + L_V, RS_N, ks * 32, ef * 16, lane);
            oacc[y] = __builtin_amdgcn_mfma_f32_16x16x32_bf16(va, ab, oacc[y], 0, 0, 0);
          }
        }
#pragma unroll
        for (int kh = 0; kh < 2; ++kh) {
          bf16x8 qb[4], sa[2][4];
#pragma unroll
          for (int k4 = 0; k4 < 4; ++k4) {
            const int ks = kh * 4 + k4;
            qb[k4] = *(const bf16x8*)(smem + L_QE + (tf * 16 + fr) * RS_W + (ks * 4 + fq) * 16);
#pragma unroll
            for (int y = 0; y < 2; ++y) sa[y][k4] = *(const bf16x8*)(smem + L_ST + (((wid & 1) * 2 + y) * 16 + fr) * RS_W + (ks * 4 + fq) * 16);
          }
          SCHED_FENCE();
#pragma unroll
          for (int k4 = 0; k4 < 4; ++k4)
#pragma unroll
            for (int y = 0; y < 2; ++y) oacc[y] = __builtin_amdgcn_mfma_f32_16x16x32_bf16(sa[y][k4], qb[k4], oacc[y], 0, 0, 0);
          SCHED_FENCE();
        }
        const int i = tf * 16 + fr;
        const int t = c * 64 - PADC + i;
        float ss = 0.f;
#pragma unroll
        for (int y = 0; y < 2; ++y)
#pragma unroll
          for (int jj = 0; jj < 4; ++jj) ss += oacc[y][jj] * oacc[y][jj];
        ss += __shfl_xor(ss, 16);
        ss += __shfl_xor(ss, 32);
        if (t >= 0) {
          const size_t row = (size_t)b * TT + t;
#pragma unroll
          for (int y = 0; y < 2; ++y) {
            const int ef = (wid & 1) * 2 + y;
            uint2 o; o.x = pack2(oacc[y][0], oacc[y][1]); o.y = pack2(oacc[y][2], oacc[y][3]);
            *(uint2*)(V + row * DIN + hh * 512 + eb * 64 + ef * 16 + fq * 4) = o;
          }
          if (fq == 0) SSQ[(row * 4 + hh) * 16 + eb * 2 + (wid & 1)] = ss;
        }
      }
      __syncthreads();
    }
  }
}

#define XB_TMO      128
#define XB_XCNT(j)  (256  + 64 * (j))
#define XB_XSUB(j)  (1280 + 64 * (j))
#define XB_XGEN(j)  (2304 + 64 * (j))
#define XB_TOP      3328
#define XB_TOPGEN   3392
#define XCD_BAR_WORDS 3456
#define XB_SPIN_CAP (1u << 22)
#define LAS __attribute__((address_space(3)))
DI unsigned xb_ld(unsigned* p) { return __hip_atomic_load(p, __ATOMIC_RELAXED, __HIP_MEMORY_SCOPE_AGENT); }
DI unsigned xb_add(unsigned* p, unsigned v) { return __hip_atomic_fetch_add(p, v, __ATOMIC_RELAXED, __HIP_MEMORY_SCOPE_AGENT); }
DI unsigned xb_xcc_id() { return (unsigned)__builtin_amdgcn_s_getreg((3 << 11) | 20) & 0xFu; }
#define XB_SPIN(cond, bar) do { unsigned _sp = 0; while (cond) { __builtin_amdgcn_s_sleep(1); \
    if ((++_sp & 255u) == 0u) { if (xb_ld(&(bar)[XB_TMO])) break; if (_sp > XB_SPIN_CAP) { atomicAdd(&(bar)[XB_TMO], 1u); break; } } } } while (0)
struct XcdBarrier { unsigned* bar; unsigned x; volatile LAS unsigned* st; };
DI XcdBarrier xcd_barrier_post(unsigned* bar, volatile LAS unsigned* st) {
  XcdBarrier b; b.bar = bar; b.x = xb_xcc_id(); b.st = st;
  if (threadIdx.x == 0) (void)xb_add(&bar[XB_XCNT(b.x)], 1u);
  return b;
}
DI void xcd_barrier_complete(unsigned* bar, unsigned x, unsigned& nloc, unsigned& nx) {
  const unsigned G = gridDim.x * gridDim.y * gridDim.z;
  unsigned sum, cnt, mine, sp = 0u;
  for (;;) {
    sum = 0u; cnt = 0u; mine = 0u;
#pragma unroll
    for (unsigned j = 0; j < 16; ++j) { const unsigned c = xb_ld(&bar[XB_XCNT(j)]); sum += c; cnt += (c > 0u) ? 1u : 0u; mine = (j == x) ? c : mine; }
    if (sum == G) break;
    __builtin_amdgcn_s_sleep(1);
    if ((++sp & 255u) == 0u) { if (xb_ld(&bar[XB_TMO])) break; if (sp > XB_SPIN_CAP) { atomicAdd(&bar[XB_TMO], 1u); break; } }
  }
  nloc = mine > 0u ? mine : 1u; nx = cnt > 0u ? cnt : 1u;
}
DI void xcd_barrier(const XcdBarrier& b) {
  asm volatile("s_waitcnt vmcnt(0)" ::: "memory");
  __syncthreads();
  if (threadIdx.x == 0) {
    unsigned* bar = b.bar;
    __builtin_amdgcn_s_waitcnt(0);
    unsigned nloc = b.st[0], nx = b.st[1];
    if (nloc == 0u) { xcd_barrier_complete(bar, b.x, nloc, nx); b.st[0] = nloc; b.st[1] = nx; }
    const unsigned old = xb_add(&bar[XB_XSUB(b.x)], 1u);
    const unsigned gen = old / nloc;
    if (old + 1u == (gen + 1u) * nloc) {
      __builtin_amdgcn_fence(__ATOMIC_RELEASE, "agent");
      asm volatile("s_waitcnt vmcnt(0)" ::: "memory");
      const unsigned og = xb_add(&bar[XB_TOP], 1u);
      const unsigned tg = og / nx;
      if (og + 1u == (tg + 1u) * nx) xb_add(&bar[XB_TOPGEN], 1u);
      else XB_SPIN(xb_ld(&bar[XB_TOPGEN]) == tg, bar);
      __builtin_amdgcn_fence(__ATOMIC_ACQUIRE, "agent");
      xb_add(&bar[XB_XGEN(b.x)], 1u);
      asm volatile("s_waitcnt vmcnt(0)" ::: "memory");
    } else {
      XB_SPIN(xb_ld(&bar[XB_XGEN(b.x)]) == gen, bar);
      __builtin_amdgcn_fence(__ATOMIC_ACQUIRE, "agent");
      asm volatile("s_waitcnt vmcnt(0)" ::: "memory");
    }
  }
  __syncthreads();
}
#define GEMM_PHASE(A_, lda_, Bt_, K_, N_, grp_, epi_, glr_) do { const auto e__ = (epi_); gemm_main(A_, lda_, Bt_, K_, N_, grp_, e__); TICK(1); gemm_mini<K_>(A_, lda_, Bt_, N_, grp_, e__, glr_); } while (0)
__global__ void __launch_bounds__(NT) trunk_megakernel(Params p) {
  cg::grid_group grid = cg::this_grid();
  u16* W = (u16*)p.out;
  const u16* xn = (const u16*)(p.ws + XN_OFF);
  u16* bufA = (u16*)(p.ws + A_OFF);
  u16* bufB = (u16*)(p.ws + B_OFF);
  const RowStat rstat{(const float*)(p.ws + PART_OFF), (const float*)(p.ws + MPART_OFF)};

  unsigned long long pacc[7] = {0, 0, 0, 0, 0, 0, 0};
  unsigned long long plast = (PROBE_SEL >= 0) ? wall_clock64() : 0ull;
  volatile LAS unsigned* xbst = (volatile LAS unsigned*)(smem + LDS_XB);
  if (threadIdx.x == 0) { xbst[0] = 0u; xbst[1] = 0u; }
  __syncthreads();
  const XcdBarrier xb = xcd_barrier_post((unsigned*)(p.ws + BAR_OFF), xbst);
  cvt_phase(p);
  norm_phase(p, 0, p.pool_norm);
  if (gridDim.x == 0x00ffffffu) grid.sync();
  GSYNC(0);
  for (int jl = 0; jl < 2; ++jl) {
    u16* Wp = W + (size_t)jl * PW_SZ;
    gemm_main(Wp + PW_GRP, 512, (const u16*)(p.ws + WUN_OFF) + (size_t)jl * 1024 * 2048, 512, 1024, false, EpiPlainBf16{Wp + PW_IN, 1024, rstat}, 2048, 2048, jl * 32);
  }
  GSYNC(0);

  for (int layer = 0; layer < 4; ++layer) {
    const int j = layer >> 1;
    if ((layer & 1) == 0) {
      const u16* Wl = W + (size_t)j * PW_SZ;
      GEMM_PHASE(xn, 1024, Wl + PW_IN, 1024, 4096, false, (EpiPoolIn{bufA, bufB, rstat}), 0);
      GSYNC(2);
      pool_phase(bufA, bufB, p.pool_scale + (size_t)j * DIN);
      GSYNC(5);
      GEMM_PHASE(bufB, DIN, Wl + PW_OUT, 2048, 1024, false, (EpiResidual{(u16*)(p.ws + XN_OFF), (float*)(p.ws + PART_OFF), (float*)(p.ws + MPART_OFF), rstat}), 0);
      GSYNC(2);
    } else {
      const u16* Wl = W + GW_BASE + (size_t)j * GW_SZ;
      GEMM_PHASE(xn, 1024, Wl + GW_A, 1024, 4096, false, (EpiQKV{bufA, bufA + (size_t)MR * 1024, bufB, (float*)(p.ws + GLR_OFF), rstat}), MR / 16);
      GSYNC(2);
      gla_prep_phase(p, j);
      GSYNC(3);
      gla_scan_phase(p);
      GSYNC(4);
      GEMM_PHASE(xn, 1024, Wl + GW_Z, 1024, 2048, false, (EpiGlaGate{bufB, (const float*)(p.ws + SSQ_OFF), p.gla_head_norm + (size_t)j * DIN, rstat}), 0);
      GSYNC(2);
      GEMM_PHASE(bufB, DIN, Wl + GW_OUT, 2048, 1024, false, (EpiResidual{(u16*)(p.ws + XN_OFF), (float*)(p.ws + PART_OFF), (float*)(p.ws + MPART_OFF), rstat}), 0);
      GSYNC(2);
    }
  }
  norm_phase(p, 2, p.final_norm);
  if (PROBE_SEL >= 0) {
    TICK(5);
    grid.sync();
    unsigned long long* pw = (unsigned long long*)(p.ws + WS_END + 1024);
    if (blockIdx.x == 0 && threadIdx.x == 0) {
      const unsigned long long tot = pacc[0] + pacc[1] + pacc[2] + pacc[3] + pacc[4] + pacc[5] + pacc[6];
      pw[0] = pacc[PROBE_SEL >= 0 ? PROBE_SEL : 0] * 200000ull / tot;
    }
    grid.sync();
    const unsigned long long n = pw[0];
    for (unsigned long long idx = (unsigned long long)blockIdx.x * NT + threadIdx.x; idx < n; idx += (unsigned long long)gridDim.x * NT) p.out[idx] += 0.05f;
  }
}

extern "C" void kernel_launch(void* const* d_in, const int* in_sizes, int n_in, void* d_out, int out_size, void* d_ws,
                              size_t ws_size, hipStream_t stream) {
  static int grid_blocks = 0;
  if (grid_blocks == 0) {
    if (ws_size < WS_END) { fprintf(stderr, "kernel_launch: workspace too small (%zu < %zu)\n", ws_size, (size_t)WS_END); grid_blocks = -1; return; }
    int dev = 0, cus = 0, per_cu = 0;
    hipGetDevice(&dev);
    hipDeviceGetAttribute(&cus, hipDeviceAttributeMultiprocessorCount, dev);
    if (hipFuncSetAttribute((const void*)trunk_megakernel, hipFuncAttributeMaxDynamicSharedMemorySize, LDS_BYTES) != hipSuccess) {
      fprintf(stderr, "kernel_launch: hipFuncSetAttribute failed\n"); grid_blocks = -1; return;
    }
    hipOccupancyMaxActiveBlocksPerMultiprocessor(&per_cu, (const void*)trunk_megakernel, NT, LDS_BYTES);
    if (per_cu < 1) { fprintf(stderr, "kernel_launch: occupancy query returned %d\n", per_cu); per_cu = 1; }
    grid_blocks = cus * per_cu;
  }
  if (grid_blocks < 0) return;
  Params p{};
  p.x = (const float*)d_in[0]; p.meta = (const float*)d_in[1]; p.final_norm = (const float*)d_in[2];
  p.pool_norm = (const float*)d_in[3]; p.pool_w_in = (const float*)d_in[4]; p.pool_w_grp = (const float*)d_in[5];
  p.pool_scale = (const float*)d_in[6]; p.pool_w_out = (const float*)d_in[7]; p.gla_norm = (const float*)d_in[8];
  p.gla_w_in = (const float*)d_in[9]; p.gla_w_gate2 = (const float*)d_in[10]; p.gla_b_gate = (const float*)d_in[11];
  p.gla_head_norm = (const float*)d_in[12]; p.gla_w_out = (const float*)d_in[13];
  p.out = (float*)d_out; p.ws = (unsigned char*)d_ws;
  if (hipMemsetAsync((unsigned char*)d_ws + BAR_OFF, 0, 16384, stream) != hipSuccess) { fprintf(stderr, "kernel_launch: memset of barrier words failed\n"); return; }
  void* args[] = {&p};
  hipError_t e = hipLaunchCooperativeKernel((const void*)trunk_megakernel, dim3(grid_blocks), dim3(NT), args, LDS_BYTES, stream);
  if (e != hipSuccess) fprintf(stderr, "cooperative launch failed: %s (grid %d)\n", hipGetErrorString(e), grid_blocks);
}
```
